# Optimizing an MI355X kernel written in HIP

```python
import math
import jax
import jax.numpy as jnp
from jax import lax
import numpy as np


D_MODEL = 2048
BATCH = 4
SEQ = 2048
DEPTH = 2

GRID_W = 64
CTX_LEN = 256

N_BRANCH = 4
MIX_W = D_MODEL // N_BRANCH

NA_HEADS = 4
NA_HEAD_DIM = MIX_W // NA_HEADS
NA_WIN_ROWS = 8
NA_WIN_COLS = 16

GLA_HEADS = 4
GLA_VAL_DIM = MIX_W // GLA_HEADS
GLA_KEY_DIM = GLA_VAL_DIM // 2
GLA_RANK = 16
GLA_TAU = 16.0
GLA_CHUNK = 64

FNET_GROUPS = 4
FNET_GROUP_DIM = MIX_W // FNET_GROUPS

DIFF_HEADS = 4
DIFF_V_DIM = MIX_W // DIFF_HEADS
DIFF_QK_DIM = DIFF_V_DIM // 2
DIFF_Q_BLOCK = 128
ROPE_BASE = 10000.0

N_GROUPS = 4
EXPERTS_PER_GROUP = 8
TOP_K_IN_GROUP = 2
EXPERT_DIM = D_MODEL // 4

DEEPNORM_ALPHA = (2 * DEPTH) ** 0.25
DEEPNORM_BETA = (8 * DEPTH) ** -0.25
LN_EPS = 1e-6
RMS_EPS = 1e-5
NEG_INF = -1e30

GLA_QK_W = GLA_HEADS * GLA_KEY_DIM
DIFF_QK_W = DIFF_HEADS * 2 * DIFF_QK_DIM
KV_SPLITS = (MIX_W, MIX_W, GLA_QK_W, MIX_W, 2 * GLA_RANK, DIFF_QK_W, MIX_W)
Q_SPLITS = (MIX_W, GLA_QK_W, MIX_W, MIX_W, DIFF_QK_W)
GATE_W = N_BRANCH * D_MODEL
ALL_SPLITS = KV_SPLITS + Q_SPLITS + (GATE_W,)
KV_COLS = sum(KV_SPLITS)
IN_COLS = sum(ALL_SPLITS)

kernel_name = 'hybrid_na_gla_fnet_diff_hmoe_dit'


def _split(x, sizes):
    return jnp.split(x, np.cumsum(sizes)[:-1].tolist(), axis=-1)


def _layer_norm(x):
    xf = x.astype(jnp.float32)
    mu = jnp.mean(xf, -1, keepdims=True)
    var = jnp.mean(jnp.square(xf - mu), -1, keepdims=True)
    return ((xf - mu) * lax.rsqrt(var + LN_EPS)).astype(x.dtype)


def _layer_norm_affine(x, g, b):
    return _layer_norm(x) * g + b


def _modulate(x, shift, scale):
    return _layer_norm(x) * (1 + scale) + shift


def _rms_norm(x, gain):
    xf = x.astype(jnp.float32)
    y = xf * lax.rsqrt(jnp.mean(jnp.square(xf), -1, keepdims=True) + RMS_EPS)
    return (y * gain.astype(jnp.float32)).astype(x.dtype)


def _heads(x, n_heads):
    b, n, _ = x.shape
    return x.reshape(b, n, n_heads, -1).transpose(0, 2, 1, 3)


def _merge_heads(x):
    b, h, n, d = x.shape
    return x.transpose(0, 2, 1, 3).reshape(b, n, h * d)


def _diff_heads(x):
    b, n, _ = x.shape
    return x.reshape(b, n, DIFF_HEADS, 2, DIFF_QK_DIM).transpose(0, 2, 3, 1, 4)


def _flip(x):
    return jnp.flip(x, axis=2)


def _axial_rope(n, dtype):
    half = DIFF_QK_DIM // 2
    inv = ROPE_BASE ** (-jnp.arange(0, half, 2, dtype=jnp.float32) / half)
    t = jnp.arange(n)
    ang_r = (t // GRID_W).astype(jnp.float32)[:, None] * inv
    ang_c = (t % GRID_W).astype(jnp.float32)[:, None] * inv
    return (jnp.cos(ang_r).astype(dtype), jnp.sin(ang_r).astype(dtype),
            jnp.cos(ang_c).astype(dtype), jnp.sin(ang_c).astype(dtype))


def _rotate(x, cos, sin):
    x1, x2 = jnp.split(x, 2, axis=-1)
    return jnp.concatenate([x1 * cos - x2 * sin, x1 * sin + x2 * cos], -1)


def _rope_2d(x, cos_r, sin_r, cos_c, sin_c):
    xr, xc = jnp.split(x, 2, axis=-1)
    return jnp.concatenate([_rotate(xr, cos_r, sin_r), _rotate(xc, cos_c, sin_c)], -1)


def _softmax_attn(q, k, v):
    s = jnp.einsum('bhqd,bhkd->bhqk', q, k).astype(jnp.float32) * (q.shape[-1] ** -0.5)
    return jnp.einsum('bhqk,bhkd->bhqd', jax.nn.softmax(s, -1).astype(v.dtype), v)


def _neighbourhood_attn(q, k, v, k_ctx, v_ctx, rpb):
    b, h, n, dh = q.shape
    rows = n // GRID_W
    kr = min(NA_WIN_ROWS, rows)
    kc = NA_WIN_COLS
    ncb = GRID_W // kc
    kcb = 2 * kc
    r = jnp.arange(rows)
    row_idx = jnp.clip(r - kr // 2, 0, rows - kr)[:, None] + jnp.arange(kr)
    j = jnp.arange(ncb)
    band_col = jnp.clip(j * kc - kc // 2, 0, GRID_W - kcb)[:, None] + jnp.arange(kcb)
    q_col = j[:, None] * kc + jnp.arange(kc)
    win_start = jnp.clip(q_col - kc // 2, 0, GRID_W - kc)
    key_col = band_col[:, None, :]
    in_win = (key_col >= win_start[..., None]) & (key_col < win_start[..., None] + kc)
    dr = row_idx - r[:, None]
    dc = key_col - q_col[..., None]
    bias = rpb[:, (dr + NA_WIN_ROWS - 1)[:, None, None, :, None],
               jnp.clip(dc + kc - 1, 0, 2 * kc - 2)[None, :, :, None, :]]
    ri = row_idx[:, None, :, None]
    ci = band_col[None, :, None, :]
    kg = k.reshape(b, h, rows, GRID_W, dh)[:, :, ri, ci]
    vg = v.reshape(b, h, rows, GRID_W, dh)[:, :, ri, ci]
    qb = q.reshape(b, h, rows, ncb, kc, dh)
    scale = dh ** -0.5
    s_lat = jnp.einsum('bhrjqd,bhrjxyd->bhrjqxy', qb, kg).astype(jnp.float32) * scale + bias[None]
    s_lat = jnp.where(in_win[:, :, None, :], s_lat, NEG_INF)
    s_ctx = jnp.einsum('bhrjqd,bhcd->bhrjqc', qb, k_ctx).astype(jnp.float32) * scale
    n_lat = kr * kcb
    p = jax.nn.softmax(jnp.concatenate([s_lat.reshape(b, h, rows, ncb, kc, n_lat), s_ctx], -1), -1)
    p = p.astype(v.dtype)
    p_lat = p[..., :n_lat].reshape(b, h, rows, ncb, kc, kr, kcb)
    o = (jnp.einsum('bhrjqxy,bhrjxyd->bhrjqd', p_lat, vg)
         + jnp.einsum('bhrjqc,bhcd->bhrjqd', p[..., n_lat:], v_ctx))
    return o.reshape(b, h, n, dh)


def _gla_chunked(q, k, v, log_a, s0):
    b, h, n, dk = q.shape
    dv = v.shape[-1]
    nc, c = n // GLA_CHUNK, GLA_CHUNK
    cum = jnp.cumsum(log_a.astype(jnp.float32).reshape(b, h, nc, c, dk), axis=3)
    last = cum[:, :, :, -1:, :]
    kf = k.astype(jnp.float32).reshape(b, h, nc, c, dk)
    vf = v.astype(jnp.float32).reshape(b, h, nc, c, dv)
    qf = q.astype(jnp.float32).reshape(b, h, nc, c, dk) * jnp.exp(cum) * (dk ** -0.5)
    k_in = kf * jnp.exp(-cum)
    k_end = kf * jnp.exp(last - cum)
    causal = jnp.tril(jnp.ones((c, c), dtype=bool))
    a = jnp.where(causal, jnp.einsum('bhnid,bhnjd->bhnij', qf, k_in), 0.0)
    o_intra = jnp.einsum('bhnij,bhnjv->bhniv', a, vf)
    u = jnp.einsum('bhnjd,bhnjv->bhndv', k_end, vf)
    g = jnp.exp(last[:, :, :, 0, :])

    def step(s, inp):
        g_c, u_c = inp
        return g_c[..., None] * s + u_c, s

    s_final, s_prev = lax.scan(step, s0.astype(jnp.float32),
                               (jnp.moveaxis(g, 2, 0), jnp.moveaxis(u, 2, 0)))
    s_prev = jnp.moveaxis(s_prev, 0, 2)
    o = o_intra + jnp.einsum('bhnid,bhndv->bhniv', qf, s_prev)
    return o.reshape(b, h, n, dv).astype(v.dtype), s_final


def _gla_final_state(k, v, log_a):
    cum = jnp.cumsum(log_a.astype(jnp.float32), axis=2)
    k_end = k.astype(jnp.float32) * jnp.exp(cum[:, :, -1:, :] - cum)
    return jnp.einsum('bhtd,bhtv->bhdv', k_end, v.astype(jnp.float32))


def _gla_output(o, r, gain):
    b, h, n, dv = o.shape
    y = _rms_norm(o.transpose(0, 2, 1, 3), gain).reshape(b, n, h * dv)
    return y * jax.nn.silu(r)


def _fourier(u):
    b, n, _ = u.shape
    ug = u.reshape(b, n, FNET_GROUPS, FNET_GROUP_DIM).astype(jnp.float32)
    y = jnp.fft.fft2(ug, axes=(1, 3), norm='ortho').real
    return y.reshape(b, n, FNET_GROUPS * FNET_GROUP_DIM).astype(u.dtype)


def _diff_attn(q, k, v, lam):
    s = jnp.einsum('bhmqd,bhmkd->bhmqk', q, k).astype(jnp.float32) * (DIFF_QK_DIM ** -0.5)
    p = jax.nn.softmax(s, -1)
    w = p[:, :, 0] - lam * p[:, :, 1]
    return jnp.einsum('bhqk,bhkd->bhqd', w.astype(v.dtype), v)


def _diff_attn_blocked(q, k, v, lam):
    b, h, m, n, d = q.shape
    nb = n // DIFF_Q_BLOCK
    qb = jnp.moveaxis(q.reshape(b, h, m, nb, DIFF_Q_BLOCK, d), 3, 0)
    ob = lax.map(lambda qq: _diff_attn(qq, k, v, lam), qb)
    return jnp.moveaxis(ob, 0, 2).reshape(b, h, n, -1)


def _diff_output(o, gain, lam_init):
    b, h, n, dv = o.shape
    return (_rms_norm(o.transpose(0, 2, 1, 3), gain) * (1.0 - lam_init)).reshape(b, n, h * dv)


def _kv_side(na_k, na_v, gla_k, gla_v, gla_lr, diff_k, diff_v, w_gate, b_gate):
    b, n, _ = na_k.shape
    z = jnp.einsum('bnsr,srk->bnsk', gla_lr.reshape(b, n, 2, GLA_RANK), w_gate) + b_gate
    log_a = jax.nn.log_sigmoid(z.astype(jnp.float32)) / GLA_TAU
    return (_heads(na_k, NA_HEADS), _heads(na_v, NA_HEADS),
            _heads(gla_k, GLA_HEADS), _heads(gla_v, GLA_HEADS),
            _heads(log_a[:, :, 0], GLA_HEADS), _heads(log_a[:, :, 1], GLA_HEADS),
            _diff_heads(diff_k), _heads(diff_v, DIFF_HEADS))


def _merge_branches(ys, gates, w_branch_l, w_out_l):
    y = jnp.stack(ys, axis=2)
    z = jnp.einsum('bngi,gid->bngd', y, w_branch_l)
    g = jax.nn.sigmoid(gates.reshape(z.shape))
    return jnp.sum(g * z, axis=2) @ w_out_l


def _context_mix(q_pieces, kv, lam, lam_init, gla_norm_l, diff_norm_l, w_branch_l, w_out_l):
    na_q, gla_q, gla_r, fnet_u, diff_q, gates = q_pieces
    na_k, na_v, gk, gv, la_f, la_b, dk, dv = kv
    b = na_q.shape[0]
    y_na = _merge_heads(_softmax_attn(_heads(na_q, NA_HEADS), na_k, na_v))
    gq = _heads(gla_q, GLA_HEADS)
    zeros = jnp.zeros((b, GLA_HEADS, GLA_KEY_DIM, GLA_VAL_DIM), jnp.float32)
    o_f, s_f = _gla_chunked(gq, gk, gv, la_f, zeros)
    o_b, s_b = _gla_chunked(_flip(gq), _flip(gk), _flip(gv), _flip(la_b), zeros)
    y_gla = _gla_output(o_f + _flip(o_b), gla_r, gla_norm_l)
    y_fnet = _fourier(fnet_u)
    y_diff = _diff_output(_diff_attn(_diff_heads(diff_q), dk, dv, lam), diff_norm_l, lam_init)
    out = _merge_branches((y_na, y_gla, y_fnet, y_diff), gates, w_branch_l, w_out_l)
    return out, s_f, s_b


def _latent_mix(q_pieces, kv, kv_ctx, s_f, s_b, rope, lam, lam_init, rpb_l, gla_norm_l,
                diff_norm_l, w_branch_l, w_out_l):
    na_q, gla_q, gla_r, fnet_u, diff_q, gates = q_pieces
    na_k, na_v, gk, gv, la_f, la_b, dk, dv = kv
    na_kc, na_vc, _, _, _, _, dkc, dvc = kv_ctx
    y_na = _merge_heads(_neighbourhood_attn(_heads(na_q, NA_HEADS), na_k, na_v, na_kc, na_vc, rpb_l))
    gq = _heads(gla_q, GLA_HEADS)
    o_f, _ = _gla_chunked(gq, gk, gv, la_f, s_f)
    o_b, _ = _gla_chunked(_flip(gq), _flip(gk), _flip(gv), _flip(la_b), s_b)
    y_gla = _gla_output(o_f + _flip(o_b), gla_r, gla_norm_l)
    y_fnet = _fourier(fnet_u)
    dq = _rope_2d(_diff_heads(diff_q), *rope)
    k_all = jnp.concatenate([dkc, _rope_2d(dk, *rope)], axis=3)
    v_all = jnp.concatenate([dvc, dv], axis=2)
    y_diff = _diff_output(_diff_attn_blocked(dq, k_all, v_all, lam), diff_norm_l, lam_init)
    return _merge_branches((y_na, y_gla, y_fnet, y_diff), gates, w_branch_l, w_out_l)


def _hier_moe(x, w_group, b_group, w_router, b_router, w_gu, w_down):
    g_logits = (x @ w_group).astype(jnp.float32) + b_group
    g_sel = jnp.argmax(g_logits, -1)
    g_w = jnp.take_along_axis(jax.nn.softmax(g_logits, -1), g_sel[:, None], 1)
    e_logits = jnp.einsum('td,gde->tge', x, w_router).astype(jnp.float32) + b_router
    e_sel = jnp.take_along_axis(e_logits, g_sel[:, None, None], 1)[:, 0]
    top_v, top_i = lax.top_k(e_sel, TOP_K_IN_GROUP)
    top_w = jax.nn.softmax(top_v, -1) * g_w
    within = jnp.sum(jax.nn.one_hot(top_i, EXPERTS_PER_GROUP, dtype=jnp.float32) * top_w[..., None], 1)
    combine = (jax.nn.one_hot(g_sel, N_GROUPS, dtype=jnp.float32)[:, :, None]
               * within[:, None, :]).astype(x.dtype)
    out = jnp.zeros_like(x)
    for g in range(N_GROUPS):
        hg, hu = jnp.split(jnp.einsum('td,edf->tef', x, w_gu[g]), 2, axis=-1)
        out = out + jnp.einsum('tef,efd->td', jax.nn.silu(hg) * hu * combine[:, g, :, None], w_down[g])
    return out


def setup_inputs(seed: int = 0) -> dict:
    key = jax.random.key(seed)
    ks = jax.random.split(key, 25)

    def nrm(k, shape, s):
        return jax.random.normal(k, shape, jnp.float32) * s

    L = DEPTH
    D = D_MODEL
    return {
        'x': nrm(ks[0], (BATCH, SEQ, D), 1.0),
        'c': nrm(ks[1], (BATCH, D), 1.0),
        'ctx': nrm(ks[2], (BATCH, CTX_LEN, D), 1.0),
        'c_ctx': nrm(ks[3], (D,), 1.0),
        'w_mod': nrm(ks[4], (L, D, 6 * D), 0.5 * D ** -0.5),
        'b_mod': nrm(ks[5], (L, 6 * D), 0.02),
        'w_in': nrm(ks[6], (L, D, IN_COLS), D ** -0.5),
        'na_rpb': nrm(ks[7], (L, NA_HEADS, 2 * NA_WIN_ROWS - 1, 2 * NA_WIN_COLS - 1), 0.1),
        'gla_w_gate': nrm(ks[8], (L, 2, GLA_RANK, GLA_QK_W), GLA_RANK ** -0.5),
        'gla_b_gate': nrm(ks[9], (L, 2, GLA_QK_W), 0.1),
        'gla_norm': 1.0 + nrm(ks[10], (L, GLA_VAL_DIM), 0.02),
        'diff_lambda': nrm(ks[11], (L, 4, DIFF_QK_DIM), 0.1),
        'diff_norm': 1.0 + nrm(ks[12], (L, DIFF_V_DIM), 0.02),
        'w_branch': nrm(ks[13], (L, N_BRANCH, MIX_W, D), DEEPNORM_BETA * MIX_W ** -0.5),
        'w_out': nrm(ks[14], (L, D, D), DEEPNORM_BETA * D ** -0.5),
        'ln1_g': 1.0 + nrm(ks[15], (L, D), 0.02),
        'ln1_b': nrm(ks[16], (L, D), 0.02),
        'ln2_g': 1.0 + nrm(ks[17], (L, D), 0.02),
        'ln2_b': nrm(ks[18], (L, D), 0.02),
        'w_group': nrm(ks[19], (L, D, N_GROUPS), D ** -0.5),
        'b_group': nrm(ks[20], (L, N_GROUPS), 0.01),
        'w_router': nrm(ks[21], (L, N_GROUPS, D, EXPERTS_PER_GROUP), D ** -0.5),
        'b_router': nrm(ks[22], (L, N_GROUPS, EXPERTS_PER_GROUP), 0.01),
        'w_gu': nrm(ks[23], (L, N_GROUPS, EXPERTS_PER_GROUP, D, 2 * EXPERT_DIM), DEEPNORM_BETA * D ** -0.5),
        'w_down': nrm(ks[24], (L, N_GROUPS, EXPERTS_PER_GROUP, EXPERT_DIM, D), DEEPNORM_BETA * EXPERT_DIM ** -0.5),
    }


def reference(x, c, ctx, c_ctx, w_mod, b_mod, w_in, na_rpb, gla_w_gate, gla_b_gate, gla_norm,
              diff_lambda, diff_norm, w_branch, w_out, ln1_g, ln1_b, ln2_g, ln2_b,
              w_group, b_group, w_router, b_router, w_gu, w_down):
    rope = _axial_rope(x.shape[1], x.dtype)
    cond_lat = jax.nn.silu(c)
    cond_ctx = jax.nn.silu(c_ctx)
    xl, xc = x, ctx
    for l in range(DEPTH):
        last = l == DEPTH - 1
        lam_init = 0.8 - 0.6 * math.exp(-0.3 * l)
        lq1, lk1, lq2, lk2 = diff_lambda[l].astype(jnp.float32)
        lam = jnp.exp(jnp.sum(lq1 * lk1)) - jnp.exp(jnp.sum(lq2 * lk2)) + lam_init
        mod_lat = jnp.split((cond_lat @ w_mod[l] + b_mod[l])[:, None, :], 6, axis=-1)
        n_ctx_mod = 2 if last else 6
        mod_ctx = jnp.split(cond_ctx @ w_mod[l][:, :n_ctx_mod * D_MODEL] + b_mod[l][:n_ctx_mod * D_MODEL],
                            n_ctx_mod, axis=-1)
        p_lat = _split(_modulate(xl, mod_lat[0], mod_lat[1]) @ w_in[l], ALL_SPLITS)
        h_ctx = _modulate(xc, mod_ctx[0], mod_ctx[1])
        if last:
            p_ctx = _split(h_ctx @ w_in[l][:, :KV_COLS], KV_SPLITS)
        else:
            p_ctx = _split(h_ctx @ w_in[l], ALL_SPLITS)
        kv_lat = _kv_side(*p_lat[:7], gla_w_gate[l], gla_b_gate[l])
        kv_ctx = _kv_side(*p_ctx[:7], gla_w_gate[l], gla_b_gate[l])
        if last:
            _, _, gk_c, gv_c, la_f_c, la_b_c, _, _ = kv_ctx
            s_f = _gla_final_state(gk_c, gv_c, la_f_c)
            s_b = _gla_final_state(_flip(gk_c), _flip(gv_c), _flip(la_b_c))
        else:
            mix_ctx, s_f, s_b = _context_mix(p_ctx[7:], kv_ctx, lam, lam_init, gla_norm[l], diff_norm[l],
                                             w_branch[l], w_out[l])
            xc = _layer_norm_affine(DEEPNORM_ALPHA * xc + mod_ctx[2] * mix_ctx, ln1_g[l], ln1_b[l])
        mix_lat = _latent_mix(p_lat[7:], kv_lat, kv_ctx, s_f, s_b, rope, lam, lam_init, na_rpb[l],
                              gla_norm[l], diff_norm[l], w_branch[l], w_out[l])
        xl = _layer_norm_affine(DEEPNORM_ALPHA * xl + mod_lat[2] * mix_lat, ln1_g[l], ln1_b[l])
        moe_w = (w_group[l], b_group[l], w_router[l], b_router[l], w_gu[l], w_down[l])
        h_lat = _modulate(xl, mod_lat[3], mod_lat[4]).reshape(-1, D_MODEL)
        if last:
            f_lat = _hier_moe(h_lat, *moe_w).reshape(xl.shape)
        else:
            h_c = _modulate(xc, mod_ctx[3], mod_ctx[4]).reshape(-1, D_MODEL)
            f_all = _hier_moe(jnp.concatenate([h_lat, h_c], axis=0), *moe_w)
            n_lat_tok = h_lat.shape[0]
            f_lat = f_all[:n_lat_tok].reshape(xl.shape)
            f_ctx = f_all[n_lat_tok:].reshape(xc.shape)
            xc = _layer_norm_affine(DEEPNORM_ALPHA * xc + mod_ctx[5] * f_ctx, ln2_g[l], ln2_b[l])
        xl = _layer_norm_affine(DEEPNORM_ALPHA * xl + mod_lat[5] * f_lat, ln2_g[l], ln2_b[l])
    return xl
```

```cpp
#include <hip/hip_runtime.h>
#include <cstdio>
#include <cstdint>
#include <cstring>

#ifndef ONE_LAUNCH
#define ONE_LAUNCH 0
#endif

typedef _Float16 f16;
typedef _Float16 f16x8 __attribute__((ext_vector_type(8)));
typedef _Float16 f16x4 __attribute__((ext_vector_type(4)));
typedef _Float16 f16x2 __attribute__((ext_vector_type(2)));
typedef float f32x4 __attribute__((ext_vector_type(4)));
typedef float f32x2 __attribute__((ext_vector_type(2)));
typedef float f32x16 __attribute__((ext_vector_type(16)));
typedef unsigned u32x4 __attribute__((ext_vector_type(4)));

#define GAS __attribute__((address_space(1)))
#define LAS __attribute__((address_space(3)))
typedef GAS unsigned gu32;
#define RLX_AGENT __ATOMIC_RELAXED, __HIP_MEMORY_SCOPE_AGENT
#define LDS_WAIT() asm volatile("s_waitcnt lgkmcnt(0)" ::: "memory")
#define VM_WAIT() asm volatile("s_waitcnt vmcnt(0)" ::: "memory")

namespace pg8 {
#define PG8_LAS __attribute__((address_space(3)))
typedef _Float16 bf16x8 __attribute__((ext_vector_type(8)));
typedef float f32x4 __attribute__((ext_vector_type(4)));
constexpr int BM = 256, BK = 64, HALF = 128, HTB = HALF * BK * 2  , STAGE_BYTES = 8 * HTB, NXCD = 8, WGM = 8;

__host__ __device__ __forceinline__ int lds_byte(int r, int c) { const int st = (r >> 4) * 2 + (c >> 5), rr = r & 15, cc = c & 31, ob = rr * 64 + cc * 2; return st * 1024 + (ob ^ (((ob >> 9) & 1) << 5)); }
__host__ __device__ __forceinline__ void stage_rc(int b, int& R, int& C) { const int st = b / 1024, sb = b % 1024, swz = sb ^ (((sb >> 9) & 1) << 5); R = (st >> 1) * 16 + swz / 64; C = (st & 1) * 32 + (swz % 64) / 2; }
__host__ __device__ __forceinline__ int perm32(int rho) { const int n = rho >> 4, i = rho & 15; return 8 * (i >> 2) + 4 * n + (i & 3); }

struct Unit { int pm, pn, kt0, tag; };
struct Gemm { const void* A; const void* Bt; int ld, nt; };

__device__ __forceinline__ void tile_of(int L, int nM, int nN, int& pm, int& pn) {
    const int nwg = nM * nN; int wgid = L;
    { const int q = nwg / NXCD, r = nwg % NXCD, xcd = wgid % NXCD, off = wgid / NXCD; wgid = (xcd < r ? xcd * (q + 1) : r * (q + 1) + (xcd - r) * q) + off; }
    const int nig = WGM * nN, gid = wgid / nig, fm = gid * WGM, gsz = (nM - fm) < WGM ? (nM - fm) : WGM;
    pm = fm + ((wgid % nig) % gsz); pn = (wgid % nig) / gsz;
}
template <class Epi, class Sched, bool ALIGN_EPI = false, bool SP2 = false>
__device__ __forceinline__ void gemm_phase(PG8_LAS unsigned char* lds, const Gemm g, const Sched& S, const Epi& E) {
    int tid_pin = threadIdx.x; asm volatile("" : "+v"(tid_pin));
    const int tid = tid_pin, wid = __builtin_amdgcn_readfirstlane(tid >> 6), lane = tid & 63, wr = wid >> 2, wc = wid & 3, fr = lane & 15, fq = lane >> 4;
    const int K = g.ld, nt = g.nt;
    unsigned voffA[2], voffB[2];
#pragma unroll
    for (int i = 0; i < 2; ++i) { int R, C; stage_rc(tid * 16 + i * 8192, R, C); const int Rb = Epi::PERM ? ((R & ~31) + perm32(R & 31)) : R;
        voffA[i] = (unsigned)(R * K + C) * 2u; voffB[i] = (unsigned)(Rb * K + C) * 2u; }
    const size_t kstep = (size_t)(BK * 2);
    const size_t hstep = (size_t)HALF * K * 2;
    const size_t tstep = 2 * hstep;
    const unsigned ldsw = (unsigned)wid * 1024u;
    const int aoff = lds_byte(wr * 64 + fr, fq * 8), boff = lds_byte(wc * 32 + fr, fq * 8);
#define PG8_SA(b, h) (((b) * 2 + (h)) * HTB)
#define PG8_SB(b, h) ((4 + (b) * 2 + (h)) * HTB)
#define PG8_STAGE(bufoff, gbase, voff) do { _Pragma("unroll") for (int _i = 0; _i < 2; ++_i) \
        __builtin_amdgcn_global_load_lds((const unsigned*)((const char*)(gbase) + (voff)[_i]), (PG8_LAS unsigned*)(lds + (bufoff) + ldsw + _i * 8192), 16, 0, 0); } while (0)
#define PG8_LDA(dst, b, h) do { _Pragma("unroll") for (int m = 0; m < 4; ++m) _Pragma("unroll") for (int k = 0; k < 2; ++k) dst[m][k] = *(const PG8_LAS bf16x8*)(lds + PG8_SA(b, h) + aoff + m * 2048 + k * 1024); } while (0)
#define PG8_LDB(dst, b, h) do { _Pragma("unroll") for (int n = 0; n < 2; ++n) _Pragma("unroll") for (int k = 0; k < 2; ++k) dst[n][k] = *(const PG8_LAS bf16x8*)(lds + PG8_SB(b, h) + boff + n * 2048 + k * 1024); } while (0)
#define PG8_MMA(ai, bj, At, Bt) do { __builtin_amdgcn_s_setprio(1); _Pragma("unroll") for (int m = 0; m < 4; ++m) _Pragma("unroll") for (int n = 0; n < 2; ++n) _Pragma("unroll") for (int k = 0; k < 2; ++k) \
        acc[ai][bj][m][n] = __builtin_amdgcn_mfma_f32_16x16x32_f16(Bt[n][k], At[m][k], acc[ai][bj][m][n], 0, 0, 0); __builtin_amdgcn_s_setprio(0); } while (0)
#define PG8_WAIT_V(n) asm volatile("s_waitcnt vmcnt(" #n ")" ::: "memory")
#define PG8_WAIT_L(n) asm volatile("s_waitcnt lgkmcnt(" #n ")" ::: "memory")
#define PG8_BAR __builtin_amdgcn_s_barrier()
#define PG8_SCHED __builtin_amdgcn_sched_barrier(0)
    Unit cur, nxt; int ui = 0;
    if (!S.next(0, cur)) return;
    cur.pm = __builtin_amdgcn_readfirstlane(cur.pm); cur.pn = __builtin_amdgcn_readfirstlane(cur.pn); cur.kt0 = __builtin_amdgcn_readfirstlane(cur.kt0); cur.tag = __builtin_amdgcn_readfirstlane(cur.tag);
    f32x4 acc[2][2][4][2];
#pragma unroll
    for (int a = 0; a < 2; ++a)
#pragma unroll
        for (int b = 0; b < 2; ++b)
#pragma unroll
            for (int m = 0; m < 4; ++m)
#pragma unroll
                for (int n = 0; n < 2; ++n) acc[a][b][m][n] = (f32x4){0.f, 0.f, 0.f, 0.f};
    bf16x8 At[4][2], B0[2][2], B1[2][2];
    const char* cA = (const char*)g.A + (size_t)cur.pm * tstep + (size_t)cur.kt0 * (size_t)(BK * 2); const char* cB = (const char*)g.Bt + (size_t)cur.pn * tstep + (size_t)cur.kt0 * (size_t)(BK * 2);
    S.a_ready(cur);
    if constexpr (SP2) {
        PG8_STAGE(PG8_SB(0, 0), cB, voffB); PG8_STAGE(PG8_SB(0, 1), cB + hstep, voffB); PG8_STAGE(PG8_SA(0, 0), cA, voffA); PG8_STAGE(PG8_SA(0, 1), cA + hstep, voffA);
        if (wr == 1) PG8_BAR;
        PG8_WAIT_V(2); PG8_BAR;
        PG8_STAGE(PG8_SB(1, 0), cB + kstep, voffB); PG8_STAGE(PG8_SA(1, 0), cA + kstep, voffA); PG8_STAGE(PG8_SB(1, 1), cB + hstep + kstep, voffB);
        PG8_WAIT_V(6); PG8_BAR;
    } else {
        PG8_STAGE(PG8_SB(0, 0), cB, voffB); PG8_STAGE(PG8_SA(0, 0), cA, voffA); PG8_STAGE(PG8_SB(0, 1), cB + hstep, voffB); PG8_STAGE(PG8_SA(0, 1), cA + hstep, voffA);
        if (wr == 1) PG8_BAR;
        PG8_WAIT_V(4); PG8_BAR;
        PG8_STAGE(PG8_SB(1, 0), cB + kstep, voffB); PG8_STAGE(PG8_SA(1, 0), cA + kstep, voffA); PG8_STAGE(PG8_SB(1, 1), cB + hstep + kstep, voffB);
        PG8_WAIT_V(6); PG8_BAR;
    }
    for (;;) {
        const bool has_next = __builtin_amdgcn_readfirstlane((int)S.next(ui + 1, nxt)) != 0;
        nxt.pm = __builtin_amdgcn_readfirstlane(nxt.pm); nxt.pn = __builtin_amdgcn_readfirstlane(nxt.pn); nxt.kt0 = __builtin_amdgcn_readfirstlane(nxt.kt0); nxt.tag = __builtin_amdgcn_readfirstlane(nxt.tag);
        const char* nA = has_next ? (const char*)g.A + (size_t)nxt.pm * tstep + (size_t)nxt.kt0 * kstep : cA; const char* nB = has_next ? (const char*)g.Bt + (size_t)nxt.pn * tstep + (size_t)nxt.kt0 * kstep : cB;
        for (int t = 0; t < nt; t += 2) {
            const bool last = (t == nt - 2);
            const char* a1 = cA + (size_t)(t + 1) * kstep;
            const char* a2 = last ? nA : cA + (size_t)(t + 2) * kstep; const char* b2 = last ? nB : cB + (size_t)(t + 2) * kstep;
            const char* a3 = a2 + kstep; const char* b3 = b2 + kstep;
            if (last && has_next) S.a_ready(nxt);
            if constexpr (SP2) {
            PG8_LDB(B0, 0, 0); PG8_LDB(B1, 0, 1); PG8_SCHED; PG8_LDA(At, 0, 0); PG8_STAGE(PG8_SA(1, 1), a1 + hstep, voffA);
            PG8_WAIT_V(8); PG8_WAIT_L(0); PG8_BAR; PG8_MMA(0, 0, At, B0); PG8_MMA(0, 1, At, B1); PG8_BAR; PG8_SCHED;
            PG8_LDA(At, 0, 1); PG8_STAGE(PG8_SB(0, 0), b2, voffB); PG8_STAGE(PG8_SB(0, 1), b2 + hstep, voffB); PG8_STAGE(PG8_SA(0, 0), a2, voffA);
            PG8_WAIT_V(8); PG8_WAIT_L(0); PG8_BAR; PG8_MMA(1, 0, At, B0); PG8_MMA(1, 1, At, B1); PG8_BAR; PG8_SCHED;
            PG8_LDB(B0, 1, 0); PG8_LDB(B1, 1, 1); PG8_SCHED; PG8_LDA(At, 1, 0); PG8_STAGE(PG8_SA(0, 1), a2 + hstep, voffA);
            PG8_WAIT_V(8); PG8_WAIT_L(0); PG8_BAR; PG8_MMA(0, 0, At, B0); PG8_MMA(0, 1, At, B1); PG8_BAR; PG8_SCHED;
            PG8_LDA(At, 1, 1); PG8_STAGE(PG8_SB(1, 0), b3, voffB); PG8_STAGE(PG8_SB(1, 1), b3 + hstep, voffB); PG8_STAGE(PG8_SA(1, 0), a3, voffA);
            PG8_WAIT_V(8); PG8_WAIT_L(0); PG8_BAR; PG8_MMA(1, 0, At, B0); PG8_MMA(1, 1, At, B1); PG8_BAR; PG8_SCHED;
            } else {
            PG8_LDB(B0, 0, 0); PG8_SCHED; PG8_LDA(At, 0, 0); PG8_STAGE(PG8_SA(1, 1), a1 + hstep, voffA);
            PG8_WAIT_L(8); PG8_BAR; PG8_WAIT_L(0); PG8_MMA(0, 0, At, B0); PG8_BAR; PG8_SCHED;
            PG8_LDB(B1, 0, 1); PG8_STAGE(PG8_SB(0, 0), b2, voffB);
            PG8_BAR; PG8_WAIT_L(0); PG8_MMA(0, 1, At, B1); PG8_BAR;
            PG8_LDA(At, 0, 1); PG8_STAGE(PG8_SA(0, 0), a2, voffA);
            PG8_BAR; PG8_WAIT_L(0); PG8_MMA(1, 0, At, B0); PG8_BAR; PG8_SCHED;
            PG8_STAGE(PG8_SB(0, 1), b2 + hstep, voffB);
            PG8_WAIT_V(6); PG8_BAR; PG8_MMA(1, 1, At, B1); PG8_BAR;
            PG8_LDB(B0, 1, 0); PG8_SCHED; PG8_LDA(At, 1, 0); PG8_STAGE(PG8_SA(0, 1), a2 + hstep, voffA);
            PG8_WAIT_L(8); PG8_BAR; PG8_WAIT_L(0); PG8_MMA(0, 0, At, B0); PG8_BAR; PG8_SCHED;
            PG8_LDB(B1, 1, 1); PG8_STAGE(PG8_SB(1, 0), b3, voffB);
            PG8_BAR; PG8_WAIT_L(0); PG8_MMA(0, 1, At, B1); PG8_BAR;
            PG8_LDA(At, 1, 1); PG8_STAGE(PG8_SA(1, 0), a3, voffA);
            PG8_BAR; PG8_WAIT_L(0); PG8_MMA(1, 0, At, B0); PG8_BAR; PG8_SCHED;
            PG8_STAGE(PG8_SB(1, 1), b3 + hstep, voffB);
            PG8_WAIT_V(6); PG8_BAR; PG8_MMA(1, 1, At, B1); PG8_BAR;
            }
        }
        if constexpr (ALIGN_EPI) { if (wr == 0) PG8_BAR; }
        if constexpr (!Epi::AFTER_DRAIN) { int fr2 = fr, fq2 = fq, wr2 = wr, wc2 = wc; asm volatile("" : "+v"(fr2), "+v"(fq2), "+s"(wr2), "+s"(wc2)); E(acc, cur, wr2, wc2, fr2, fq2); S.done(cur); }
        if (!has_next) break;
#pragma unroll
        for (int a = 0; a < 2; ++a)
#pragma unroll
            for (int b = 0; b < 2; ++b)
#pragma unroll
                for (int m = 0; m < 4; ++m)
#pragma unroll
                    for (int n = 0; n < 2; ++n) acc[a][b][m][n] = (f32x4){0.f, 0.f, 0.f, 0.f};
        cur = nxt; cA = nA; cB = nB; ++ui;
        if constexpr (ALIGN_EPI) { if (wr == 1) PG8_BAR; }
    }
    PG8_WAIT_V(0);
    if constexpr (!ALIGN_EPI) { if (wr == 0) PG8_BAR; }
    PG8_BAR;
    if constexpr (Epi::AFTER_DRAIN) { E.fused(acc, cur, wr, wc, fr, fq, lds, wid, lane); S.done(cur); }
#undef PG8_SA
#undef PG8_SB
#undef PG8_STAGE
#undef PG8_LDA
#undef PG8_LDB
#undef PG8_MMA
#undef PG8_WAIT_V
#undef PG8_WAIT_L
#undef PG8_BAR
#undef PG8_SCHED
}
}

constexpr int D = 2048, NB = 4, SEQ = 2048, CTXL = 256, TL = NB * SEQ, TC = NB * CTXL, T = TL + TC;
constexpr int NMAIN = 12032;
constexpr int C_NAK = 0, C_GK = 512, C_GV = 768, C_LR = 1280, C_DK = 1312, C_NAQ = 1824, C_GQ = 2336, C_GR = 2592, C_DQ = 3104, C_GATE = 3616;
constexpr int IN_COLS = 13344;
constexpr int KVPOS = 2304;
constexpr int NWAVES = 8, NTHR = 512;
constexpr float LN_EPS = 1e-6f, RMS_EPS = 1e-5f, ALPHA = 1.4142135623730951f;
constexpr int MAXSLOT = 26624;
constexpr int N_PHASES = 2 + 2 * 11;

constexpr size_t MiB = 1u << 20;
constexpr size_t WS_CTL = 0, CTL_ZERO_BYTES = MiB;
constexpr size_t WS_MOD = 1 * MiB, WS_ROUT = 2 * MiB, WS_SLOTW = 3 * MiB, WS_TILES = 3 * MiB + 512 * 1024;
constexpr int WT0 = 4, WT_STRIDE = 55, HT = 114;
constexpr size_t WS_WIN = (size_t)WT0 * MiB, WS_H = (size_t)HT * MiB;
constexpr size_t WS_WBR = 150 * MiB, WS_WOUT = 166 * MiB, WS_WGU = 182 * MiB, WS_WDN = 438 * MiB, WS_TBLL = 566 * MiB, WS_TBLC = 582 * MiB;
constexpr size_t WS_P = 583 * MiB, WS_VTNA = 795 * MiB, WS_VTDF = 804 * MiB, WS_FTL = 813 * MiB, WS_FTC = 829 * MiB, WS_DQ = 831 * MiB, WS_KALL = 839 * MiB;
constexpr size_t WS_YALL = 848 * MiB, WS_GU = 884 * MiB, WS_GS = 920 * MiB, WS_GG = 956 * MiB, WS_FP = 957 * MiB, WS_S16 = 1021 * MiB, WS_S32 = 1057 * MiB;
constexpr size_t WS_XL = 1129 * MiB, WS_ASORT = 1201 * MiB, WS_ACT = 1305 * MiB, WS_SOUT = 1331 * MiB, WS_END = 1435 * MiB;
static_assert(WS_H + (size_t)T * D * 2 <= WS_WBR && WS_P + (size_t)T * NMAIN * 2 <= WS_VTNA && WS_WIN + 2 * (size_t)WT_STRIDE * MiB <= WS_H, "ws map");
constexpr int CW_TMO = 0, CW_CODE = 1, CW_BAR = 4096, CW_CNT = 16384;

constexpr int RING_OFF = 0, SCR_LIMIT = 143360;
constexpr int TBL_OFF = 143360;
constexpr int MISC_OFF = 146944;
constexpr int LDS_BYTES = 147456;

#define XB_TMO      128
#define XB_XCNT(j)  (256  + 64 * (j))
#define XB_XSUB(j)  (1280 + 64 * (j))
#define XB_XGEN(j)  (2304 + 64 * (j))
#define XB_TOP      3328
#define XB_TOPGEN   3392
#define XCD_BAR_WORDS 3456
#define XB_SPIN_CAP (1u << 18)

__device__ __forceinline__ unsigned xb_ld(unsigned* p)              { return __hip_atomic_load(p, __ATOMIC_RELAXED, __HIP_MEMORY_SCOPE_AGENT); }
__device__ __forceinline__ unsigned xb_add(unsigned* p, unsigned v) { return __hip_atomic_fetch_add(p, v, __ATOMIC_RELAXED, __HIP_MEMORY_SCOPE_AGENT); }
__device__ __forceinline__ unsigned xb_xcc_id() { return (unsigned)__builtin_amdgcn_s_getreg((3 << 11) | 20) & 0xFu; }
#define XB_SPIN(cond, bar) do { unsigned _sp = 0; while (cond) { __builtin_amdgcn_s_sleep(1); \
    if ((++_sp & 255u) == 0u) { if (xb_ld(&(bar)[XB_TMO])) break; if (_sp > XB_SPIN_CAP) { atomicAdd(&(bar)[XB_TMO], 1u); break; } } } } while (0)

struct XcdBarrier {
    unsigned* bar; unsigned x;
    volatile LAS unsigned* st;
};

__device__ __forceinline__ XcdBarrier xcd_barrier_post(unsigned* bar, volatile LAS unsigned* st) {
    XcdBarrier b; b.bar = bar; b.x = xb_xcc_id(); b.st = st;
    if (threadIdx.x == 0) (void)xb_add(&bar[XB_XCNT(b.x)], 1u);
    return b;
}
__device__ __forceinline__ void xcd_barrier_complete(unsigned* bar, unsigned x, unsigned& nloc, unsigned& nx) {
    const unsigned G = gridDim.x * gridDim.y * gridDim.z;
    unsigned sum, cnt, mine, sp = 0u;
    for (;;) {
        sum = 0u; cnt = 0u; mine = 0u;
#pragma unroll
        for (unsigned j = 0; j < 16; ++j) { const unsigned c = xb_ld(&bar[XB_XCNT(j)]); sum += c; cnt += (c > 0u) ? 1u : 0u; mine = (j == x) ? c : mine; }
        if (sum == G) break;
        __builtin_amdgcn_s_sleep(1);
        if ((++sp & 255u) == 0u) { if (xb_ld(&bar[XB_TMO])) break; if (sp > XB_SPIN_CAP) { atomicAdd(&bar[XB_TMO], 1u); break; } }
    }
    nloc = mine > 0u ? mine : 1u; nx = cnt > 0u ? cnt : 1u;
}

__device__ __forceinline__ void xcd_barrier(const XcdBarrier& b) {
    asm volatile("s_waitcnt vmcnt(0)" ::: "memory");
    __syncthreads();
    if (threadIdx.x == 0) {
        unsigned* bar = b.bar;
        __builtin_amdgcn_s_waitcnt(0);
        unsigned nloc = b.st[0], nx = b.st[1];
        if (nloc == 0u) { xcd_barrier_complete(bar, b.x, nloc, nx); b.st[0] = nloc; b.st[1] = nx; }
        const unsigned old = xb_add(&bar[XB_XSUB(b.x)], 1u);
        const unsigned gen = old / nloc;
        if (old + 1u == (gen + 1u) * nloc) {
            __builtin_amdgcn_fence(__ATOMIC_RELEASE, "agent");
            asm volatile("s_waitcnt vmcnt(0)" ::: "memory");
            const unsigned og = xb_add(&bar[XB_TOP], 1u);
            const unsigned tg = og / nx;
            if (og + 1u == (tg + 1u) * nx) xb_add(&bar[XB_TOPGEN], 1u);
            else XB_SPIN(xb_ld(&bar[XB_TOPGEN]) == tg, bar);
            __builtin_amdgcn_fence(__ATOMIC_ACQUIRE, "agent");
            xb_add(&bar[XB_XGEN(b.x)], 1u);
            asm volatile("s_waitcnt vmcnt(0)" ::: "memory");
        } else {
            XB_SPIN(xb_ld(&bar[XB_XGEN(b.x)]) == gen, bar);
            __builtin_amdgcn_fence(__ATOMIC_ACQUIRE, "agent");
            asm volatile("s_waitcnt vmcnt(0)" ::: "memory");
        }
    }
    __syncthreads();
}


struct Args { const float* in[25]; float* out; unsigned char* ws; int ph_lo, ph_hi; };
typedef const __attribute__((address_space(4))) Args* KA;

__device__ __forceinline__ float shx(float v, int o, int lane) { return __builtin_bit_cast(float, __builtin_amdgcn_ds_bpermute((lane ^ o) << 2, __builtin_bit_cast(int, v))); }
__device__ __forceinline__ float wave_sum(float v, int lane) {
#pragma unroll
    for (int o = 1; o < 64; o <<= 1) v += shx(v, o, lane);
    return v;
}
__device__ __forceinline__ float siluf(float x) { return x / (1.f + __expf(-x)); }
__device__ __forceinline__ float sigmf(float x) { return 1.f / (1.f + __expf(-x)); }
__device__ __forceinline__ f16x8 pack8(const f32x4 a, const f32x4 b) {
    f16x8 o; o[0] = (f16)a[0]; o[1] = (f16)a[1]; o[2] = (f16)a[2]; o[3] = (f16)a[3]; o[4] = (f16)b[0]; o[5] = (f16)b[1]; o[6] = (f16)b[2]; o[7] = (f16)b[3]; return o;
}
__device__ __forceinline__ f32x4 mfma16(const f16x8 a, const f16x8 b, const f32x4 c) { return __builtin_amdgcn_mfma_f32_16x16x32_f16(a, b, c, 0, 0, 0); }

__device__ __forceinline__ void row_load(const float* p, int lane, f32x4 (&v)[8]) {
#pragma unroll
    for (int j = 0; j < 8; ++j) v[j] = *(const f32x4*)(p + 4 * (lane + 64 * j));
}
__device__ __forceinline__ void row_ln(f32x4 (&v)[8], int lane) {
    float s = 0.f;
#pragma unroll
    for (int j = 0; j < 8; ++j) s += (v[j][0] + v[j][1]) + (v[j][2] + v[j][3]);
    const float mean = wave_sum(s, lane) * (1.f / D);
    float q = 0.f;
#pragma unroll
    for (int j = 0; j < 8; ++j) { v[j] = v[j] - mean; q += (v[j][0] * v[j][0] + v[j][1] * v[j][1]) + (v[j][2] * v[j][2] + v[j][3] * v[j][3]); }
    const float rstd = 1.f / sqrtf(wave_sum(q, lane) * (1.f / D) + LN_EPS);
#pragma unroll
    for (int j = 0; j < 8; ++j) v[j] = v[j] * rstd;
}
__device__ __forceinline__ void row_modulate_store(f32x4 (&v)[8], const float* shift, const float* scale, f16* orow, int lane) {
    row_ln(v, lane);
#pragma unroll
    for (int j = 0; j < 8; ++j) {
        const int c = 4 * (lane + 64 * j);
        const f32x4 sh = *(const f32x4*)(shift + c), sc = *(const f32x4*)(scale + c);
        const f32x4 y = v[j] * (sc + 1.f) + sh;
        f16x4 o; o[0] = (f16)y[0]; o[1] = (f16)y[1]; o[2] = (f16)y[2]; o[3] = (f16)y[3];
        *(f16x4*)(orow + c) = o;
    }
}
__device__ __forceinline__ const float* mod_vec(KA a, int l, int brow, int which) { return (const float*)(a->ws + WS_MOD) + ((size_t)(l * 5 + brow) * 6 + which) * D; }
__device__ __forceinline__ int brow_of(int t) { return t < TL ? (t >> 11) : 4; }

__device__ __forceinline__ void ph_mod_tables(KA a, LAS unsigned char* lds, int tid, int bid, int G) {
    LAS float* cond = (LAS float*)lds;
    LAS float* red = cond + 5 * 2048;
    LAS float* ctab = red + 16 * 5 * 128;
    const float* c = a->in[1]; const float* cctx = a->in[3];
    for (int i = tid; i < 5 * 2048; i += NTHR) { const int r = i >> 11, k = i & 2047; const float v = r < 4 ? c[r * 2048 + k] : cctx[k]; cond[i] = v / (1.f + expf(-v)); }
    for (int i = tid; i < 2048; i += NTHR) ctab[i] = cospif((float)i * (1.f / 1024.f));
    __syncthreads();
    float* MOD = (float*)(a->ws + WS_MOD);
    for (int chunk = bid; chunk < 192; chunk += G) {
        const int l = chunk / 96, col0 = (chunk % 96) * 128, cg = tid & 31, ks = tid >> 5;
        const float* wp = a->in[4] + ((size_t)l * 2048 + ks * 128) * 12288 + col0 + 4 * cg;
        f32x4 acc[5];
#pragma unroll
        for (int r = 0; r < 5; ++r) acc[r] = (f32x4){0.f, 0.f, 0.f, 0.f};
#pragma unroll 4
        for (int k = 0; k < 128; ++k) {
            const f32x4 w = *(const f32x4*)(wp + (size_t)k * 12288);
#pragma unroll
            for (int r = 0; r < 5; ++r) acc[r] += cond[r * 2048 + ks * 128 + k] * w;
        }
#pragma unroll
        for (int r = 0; r < 5; ++r) *(LAS f32x4*)(red + (ks * 5 + r) * 128 + 4 * cg) = acc[r];
        __syncthreads();
        for (int o = tid; o < 640; o += NTHR) {
            const int r = o >> 7, cc = o & 127; float s = 0.f;
#pragma unroll
            for (int k2 = 0; k2 < 16; ++k2) s += red[(k2 * 5 + r) * 128 + cc];
            MOD[(size_t)(l * 5 + r) * 12288 + col0 + cc] = s + a->in[5][l * 12288 + col0 + cc];
        }
        __syncthreads();
    }
    f16* TLp = (f16*)(a->ws + WS_TBLL);
    for (int g = bid * NTHR + tid; g < 2048 * 512; g += G * NTHR) {
        const int k1 = g >> 9, j0 = (g & 511) * 8; f16x8 o;
#pragma unroll
        for (int e = 0; e < 8; ++e) { const int j = j0 + e, n = j & 2047, m = (k1 * n) & 2047; const float v = (j < 2048) ? ctab[m] : -ctab[(m + 1536) & 2047]; o[e] = (f16)(v * 0.022097086912079608f); }
        *(f16x8*)(TLp + (size_t)k1 * 4096 + j0) = o;
    }
    f16* TCp = (f16*)(a->ws + WS_TBLC);
    for (int g = bid * NTHR + tid; g < 256 * 64; g += G * NTHR) {
        const int k1 = g >> 6, j0 = (g & 63) * 8; f16x8 o;
#pragma unroll
        for (int e = 0; e < 8; ++e) { const int j = j0 + e, n = j & 255, m = ((k1 * n) & 255) * 8; const float v = (j < 256) ? ctab[m] : -ctab[(m + 1536) & 2047]; o[e] = (f16)(v * 0.0625f); }
        *(f16x8*)(TCp + (size_t)k1 * 512 + j0) = o;
    }
}

__device__ __forceinline__ void tr_item(const float* W, int N, int K, f16* WT, int drow0, int sc0, int sc1, int k0, LAS float* scr, int lane) {
    const int sc = (lane < 32) ? (sc0 + lane) : (sc1 + lane - 32);
    const float* src = W + (size_t)k0 * N + sc;
#pragma unroll 8
    for (int i = 0; i < 64; ++i) scr[i * 65 + lane] = src[(size_t)i * N];
    LDS_WAIT(); asm volatile("" ::: "memory");
    const int c = lane & 7;
#pragma unroll
    for (int j = 0; j < 8; ++j) {
        const int n = (lane >> 3) + 8 * j; const LAS float* s = scr + (8 * c) * 65 + n; f16x8 o;
#pragma unroll
        for (int e = 0; e < 8; ++e) o[e] = (f16)s[e * 65];
        *(f16x8*)(WT + (size_t)(drow0 + n) * K + k0 + 8 * c) = o;
    }
    LDS_WAIT(); asm volatile("" ::: "memory");
}
__device__ __forceinline__ int win_src_col(int drow) {
    if (drow < 512) return drow;
    if (drow < 768) return 1024 + (drow - 512);
    if (drow < 1280) return 1280 + (drow - 768);
    if (drow < 1312) return 1792 + (drow - 1280);
    if (drow < 1824) return 1824 + (drow - 1312);
    if (drow < 2336) return 2848 + (drow - 1824);
    if (drow < 2592) return 3360 + (drow - 2336);
    if (drow < 3104) return 3616 + (drow - 2592);
    if (drow < 3616) return 4640 + (drow - 3104);
    if (drow < 11808) return 5152 + (drow - 3616);
    return 5152;
}
__device__ __forceinline__ void ph_convert(KA a, LAS unsigned char* lds, int tid, int bid, int G) {
    const int lane = tid & 63, wave = tid >> 6;
    LAS float* scr = (LAS float*)(lds + wave * 16640);
    const int gw = bid * NWAVES + wave, NGW = G * NWAVES;
    constexpr int I_MAIN = 185 * 32, I_VT = 16 * 32, I_BR = 4 * 32 * 8, I_OUT = 32 * 32, I_GU = 32 * 16 * 32, I_DN = 32 * 32 * 8;
    constexpr int I_L = I_MAIN + I_VT + I_BR + I_OUT + I_GU + I_DN;
    for (int it = gw; it < 2 * I_L; it += NGW) {
        const int l = it / I_L; int r = it % I_L;
        f16* WinT = (f16*)(a->ws + WS_WIN) + (size_t)l * WT_STRIDE * 256 * 2048;
        if (r < I_MAIN) { const int db = r >> 5, kb = r & 31; const int d0 = db * 64;
            tr_item(a->in[6] + (size_t)l * D * IN_COLS, IN_COLS, D, WinT, d0, win_src_col(d0), win_src_col(d0 + 32), kb * 64, scr, lane); continue; }
        r -= I_MAIN;
        if (r < I_VT) { const int db = r >> 5, kb = r & 31; const int sc = db < 8 ? 512 + 64 * db : 2336 + 64 * (db - 8);
            tr_item(a->in[6] + (size_t)l * D * IN_COLS, IN_COLS, D, WinT, NMAIN + db * 64, sc, sc + 32, kb * 64, scr, lane); continue; }
        r -= I_VT;
        if (r < I_BR) { const int g = r >> 8, rr = r & 255, nb = rr >> 3, kb = rr & 7;
            tr_item(a->in[13] + (size_t)(l * 4 + g) * 512 * D, D, 512, (f16*)(a->ws + WS_WBR) + (size_t)(l * 4 + g) * D * 512, nb * 64, nb * 64, nb * 64 + 32, kb * 64, scr, lane); continue; }
        r -= I_BR;
        if (r < I_OUT) { const int nb = r >> 5, kb = r & 31;
            tr_item(a->in[14] + (size_t)l * D * D, D, D, (f16*)(a->ws + WS_WOUT) + (size_t)l * D * D, nb * 64, nb * 64, nb * 64 + 32, kb * 64, scr, lane); continue; }
        r -= I_OUT;
        if (r < I_GU) { const int e = r >> 9, rr = r & 511, db = rr >> 5, kb = rr & 31;
            const int d32a = 2 * db, d32b = 2 * db + 1;
            const int sa = ((d32a & 7) >> 2) * 512 + 128 * (d32a >> 3) + 32 * (d32a & 3), sb = ((d32b & 7) >> 2) * 512 + 128 * (d32b >> 3) + 32 * (d32b & 3);
            tr_item(a->in[23] + (size_t)(l * 32 + e) * D * 1024, 1024, D, (f16*)(a->ws + WS_WGU) + (size_t)(l * 32 + e) * 1024 * D, db * 64, sa, sb, kb * 64, scr, lane); continue; }
        r -= I_GU;
        { const int e = r >> 8, rr = r & 255, nb = rr >> 3, kb = rr & 7;
            tr_item(a->in[24] + (size_t)(l * 32 + e) * 512 * D, D, 512, (f16*)(a->ws + WS_WDN) + (size_t)(l * 32 + e) * D * 512, nb * 64, nb * 64, nb * 64 + 32, kb * 64, scr, lane); }
    }
    __syncthreads();
    {
        LAS float* Wt = (LAS float*)lds;
        LAS float* tab = Wt + 64 * 129;
        for (int u = bid; u < 256; u += G) {
            const int l = u >> 7, g = (u >> 5) & 3, kc = u & 31, k0 = kc * 64;
            const float* src = a->in[6] + ((size_t)l * D + k0) * IN_COLS + 4128 + g * 128;
            for (int i = tid; i < 64 * 128; i += NTHR) { const int kk = i >> 7, c = i & 127; Wt[kk * 129 + c] = src[(size_t)kk * IN_COLS + c]; }
            if (tid < 128) tab[tid] = cospif((float)tid * (1.f / 64.f));
            __syncthreads();
            const int kk = tid & 63, rb = tid >> 6;
            float acc[32];
#pragma unroll
            for (int j = 0; j < 32; ++j) acc[j] = 0.f;
            for (int c = 0; c < 128; ++c) {
                const float w = Wt[kk * 129 + c];
#pragma unroll
                for (int j = 0; j < 32; ++j) { const int rr = rb + 8 * j, k2 = rr & 127, trig = rr >> 7; const int m = (k2 * c + (trig ? 96 : 0)) & 127; acc[j] += w * tab[m]; }
            }
            f16* WinT = (f16*)(a->ws + WS_WIN) + (size_t)l * WT_STRIDE * 256 * 2048;
#pragma unroll
            for (int j = 0; j < 32; ++j) { const int rr = rb + 8 * j, k2 = rr & 127, trig = rr >> 7;
                WinT[(size_t)(NMAIN + 1024 + trig * 512 + g * 128 + k2) * D + k0 + kk] = (f16)(acc[j] * 0.08838834764831845f); }
            __syncthreads();
        }
    }
    {
        f16* H = (f16*)(a->ws + WS_H);
        for (int t = gw; t < T; t += NGW) {
            const float* src = t < TL ? a->in[0] + (size_t)t * D : a->in[2] + (size_t)(t - TL) * D;
            f32x4 v[8]; row_load(src, lane, v);
            const int br = brow_of(t);
            row_modulate_store(v, mod_vec(a, 0, br, 0), mod_vec(a, 0, br, 1), H + (size_t)t * D, lane);
        }
    }
}

struct InProjSched {
    int G, c, l;
    __device__ __forceinline__ bool next(int i, pg8::Unit& u) const {
        int L = i * G + c, pm, pn; u.kt0 = 0; const int wt = WT0 + WT_STRIDE * l;
        if (l == 0) {
            if (L < 36 * 47) { pg8::tile_of(L, 36, 47, pm, pn); u.pm = HT + pm; u.pn = wt + pn; u.tag = 0; return true; } L -= 36 * 47;
            if (L < 8 * 36) { pg8::tile_of(L, 8, 36, pm, pn); u.pm = wt + 47 + pm; u.pn = HT + pn; u.tag = 1; return true; }
            return false;
        }
        if (L < 32 * 47) { pg8::tile_of(L, 32, 47, pm, pn); u.pm = HT + pm; u.pn = wt + pn; u.tag = 0; return true; } L -= 32 * 47;
        if (L < 4 * 8) { pg8::tile_of(L, 4, 8, pm, pn); u.pm = HT + 32 + pm; u.pn = wt + pn; u.tag = 0; return true; } L -= 4 * 8;
        if (L < 8 * 32) { pg8::tile_of(L, 8, 32, pm, pn); u.pm = wt + 47 + pm; u.pn = HT + pn; u.tag = 1; return true; } L -= 8 * 32;
        if (L < 4 * 4) { pg8::tile_of(L, 4, 4, pm, pn); u.pm = wt + 47 + pm; u.pn = HT + 32 + pn; u.tag = 1; return true; }
        return false;
    }
    __device__ __forceinline__ void a_ready(const pg8::Unit&) const {}
    __device__ __forceinline__ void done(const pg8::Unit&) const {}
};
struct Merge2Sched {
    int G, c, nM;
    __device__ __forceinline__ bool next(int i, pg8::Unit& u) const { const int L = i * G + c; if (L >= nM * 8) return false; int pm, pn; pg8::tile_of(L, nM, 8, pm, pn); u.pm = pm; u.pn = pn; u.kt0 = 0; u.tag = 0; return true; }
    __device__ __forceinline__ void a_ready(const pg8::Unit&) const {}
    __device__ __forceinline__ void done(const pg8::Unit&) const {}
};

struct EpiInProj {
    static constexpr bool PERM = true, AFTER_DRAIN = false;
    unsigned char* ws; int wt;
    __device__ __forceinline__ void operator()(const f32x4 (&acc)[2][2][4][2], const pg8::Unit& u, int wr, int wc, int fr, int fq) const {
        if (u.tag == 0) {
            f16* P = (f16*)(ws + WS_P);
            const int row0 = (u.pm - HT) * 256 + wr * 64 + fr, col0 = (u.pn - wt) * 256 + wc * 32 + 8 * fq;
#pragma unroll
            for (int ai = 0; ai < 2; ++ai)
#pragma unroll
                for (int m = 0; m < 4; ++m) { f16* rowp = P + (size_t)(row0 + ai * 128 + m * 16) * NMAIN + col0;
#pragma unroll
                    for (int bj = 0; bj < 2; ++bj) *(f16x8*)(rowp + bj * 128) = pack8(acc[ai][bj][m][0], acc[ai][bj][m][1]); }
        } else {
            const int feat0 = (u.pm - wt - 47) * 256 + wr * 64 + fr, tok0 = (u.pn - HT) * 256 + wc * 32 + 8 * fq;
#pragma unroll
            for (int ai = 0; ai < 2; ++ai)
#pragma unroll
                for (int m = 0; m < 4; ++m) { const int feat = feat0 + ai * 128 + m * 16, seg = feat >> 9, f = feat & 511;
#pragma unroll
                    for (int bj = 0; bj < 2; ++bj) { const int tok = tok0 + bj * 128; f16* dst;
                        if (tok < TL) { const int b = tok >> 11, n = tok & 2047;
                            if (seg < 2) dst = (f16*)(ws + (seg == 0 ? WS_VTNA : WS_VTDF)) + (size_t)(b * 512 + f) * KVPOS + 256 + n;
                            else dst = (f16*)(ws + WS_FTL) + (size_t)(b * 512 + f) * 4096 + (seg - 2) * 2048 + n;
                        } else { const int t = tok - TL, b = t >> 8, tt = t & 255;
                            if (seg < 2) dst = (f16*)(ws + (seg == 0 ? WS_VTNA : WS_VTDF)) + (size_t)(b * 512 + f) * KVPOS + tt;
                            else dst = (f16*)(ws + WS_FTC) + (size_t)(b * 512 + f) * 512 + (seg - 2) * 256 + tt;
                        }
                        *(f16x8*)dst = pack8(acc[ai][bj][m][0], acc[ai][bj][m][1]); } }
        }
    }
};

__device__ __forceinline__ int gla_uid(int s, int h, int dir, int c) { return s < 4 ? ((s * 4 + h) * 2 + dir) * 32 + c : 1024 + (((s - 4) * 4 + h) * 2 + dir) * 4 + c; }
constexpr int GL_Q = 0, GL_K = 4160, GL_CUM = 8320, GL_SST = 4160, GL_V = 12480, GL_AM = 20736, GL_OS = 24896, GL_LR = 33152, GL_PART = 34176;
__device__ __forceinline__ int gla_tok(int s, int dir, int c, int i) { const int L = s < 4 ? 2048 : 256; const int pos = dir ? (L - 1 - (64 * c + i)) : (64 * c + i); return s < 4 ? s * 2048 + pos : TL + (s - 4) * 256 + pos; }
__device__ __forceinline__ void gla_load_chunk(KA a, LAS float* F, int l, int s, int h, int dir, int c, bool with_q, int tid) {
    const f16* P = (const f16*)(a->ws + WS_P);
    { const int i = tid >> 3, cc = (tid & 7) * 8; const f16* row = P + (size_t)gla_tok(s, dir, c, i) * NMAIN;
      const f16x8 kv = *(const f16x8*)(row + C_GK + h * 64 + cc);
#pragma unroll
      for (int e = 0; e < 8; ++e) F[GL_K + i * 65 + cc + e] = (float)kv[e];
      if (with_q) { const f16x8 qv = *(const f16x8*)(row + C_GQ + h * 64 + cc);
#pragma unroll
          for (int e = 0; e < 8; ++e) F[GL_Q + i * 65 + cc + e] = (float)qv[e]; } }
#pragma unroll
    for (int p = 0; p < 2; ++p) { const int idx = tid + p * NTHR, i = idx >> 4, cc = (idx & 15) * 8;
      const f16x8 vv = *(const f16x8*)(P + (size_t)gla_tok(s, dir, c, i) * NMAIN + C_GV + h * 128 + cc);
#pragma unroll
      for (int e = 0; e < 8; ++e) F[GL_V + i * 129 + cc + e] = (float)vv[e]; }
    if (tid < 128) { const int i = tid >> 1, cc = (tid & 1) * 8;
      const f16x8 lv = *(const f16x8*)(P + (size_t)gla_tok(s, dir, c, i) * NMAIN + C_LR + dir * 16 + cc);
#pragma unroll
      for (int e = 0; e < 8; ++e) F[GL_LR + i * 16 + cc + e] = (float)lv[e]; }
    __syncthreads();
    { const int d = tid & 63, grp = tid >> 6;
      const float* wg = a->in[8] + (size_t)((l * 2 + dir) * 16) * 256 + h * 64 + d;
      float w[16];
#pragma unroll
      for (int r = 0; r < 16; ++r) w[r] = wg[r * 256];
      const float bias = a->in[9][(l * 2 + dir) * 256 + h * 64 + d];
      float run = 0.f;
#pragma unroll
      for (int r8 = 0; r8 < 8; ++r8) { const int i = grp * 8 + r8; float z = bias;
#pragma unroll
          for (int r = 0; r < 16; ++r) z += F[GL_LR + i * 16 + r] * w[r];
          const float la = (fminf(z, 0.f) - log1pf(expf(-fabsf(z)))) * (1.f / 16.f);
          run += la; F[GL_CUM + i * 65 + d] = run; }
      F[GL_PART + grp * 64 + d] = run;
      __syncthreads();
      float off = 0.f;
      for (int g2 = 0; g2 < grp; ++g2) off += F[GL_PART + g2 * 64 + d];
#pragma unroll
      for (int r8 = 0; r8 < 8; ++r8) F[GL_CUM + (grp * 8 + r8) * 65 + d] += off;
    }
    __syncthreads();
}
__device__ __forceinline__ void gla_g1_unit(KA a, LAS float* F, int l, int s, int h, int dir, int c, int tid) {
    gla_load_chunk(a, F, l, s, h, dir, c, false, tid);
    const int uid = gla_uid(s, h, dir, c);
    for (int idx = tid; idx < 4096; idx += NTHR) { const int i = idx >> 6, d = idx & 63; F[GL_K + i * 65 + d] *= expf(F[GL_CUM + 63 * 65 + d] - F[GL_CUM + i * 65 + d]); }
    if (tid < 64) ((float*)(a->ws + WS_GG))[(size_t)uid * 64 + tid] = expf(F[GL_CUM + 63 * 65 + tid]);
    __syncthreads();
    const int lane = tid & 63, w = tid >> 6, mi = w >> 2, nj = w & 3, r = lane & 31, hk = lane >> 5;
    f32x16 acc;
#pragma unroll
    for (int e = 0; e < 16; ++e) acc[e] = 0.f;
#pragma unroll 8
    for (int t0 = 0; t0 < 64; t0 += 2) { const float av = F[GL_K + (t0 + hk) * 65 + 32 * mi + r], bv = F[GL_V + (t0 + hk) * 129 + 32 * nj + r]; acc = __builtin_amdgcn_mfma_f32_32x32x2f32(av, bv, acc, 0, 0, 0); }
    float* U = (float*)(a->ws + WS_GU) + (size_t)uid * 8192;
#pragma unroll
    for (int e = 0; e < 16; ++e) { const int row = 32 * mi + (e & 3) + 8 * (e >> 2) + 4 * hk; U[row * 128 + 32 * nj + r] = acc[e]; }
    __syncthreads();
}
__device__ __forceinline__ void gla_scan(KA a, int tid, int bid, int G) {
    const float* __restrict__ U = (const float*)(a->ws + WS_GU); const float* __restrict__ GGp = (const float*)(a->ws + WS_GG); float* __restrict__ S = (float*)(a->ws + WS_GS);
    for (int u = bid; u < 512; u += G) {
        const int seq = u >> 4, part = u & 15;
        const int idx = part * NTHR + tid, dk = idx >> 7;
        const int uC = 1024 + seq * 4, uL = seq * 32;
        float s = 0.f;
#pragma unroll
        for (int c = 0; c < 4; ++c) { const float uu = U[(size_t)(uC + c) * 8192 + idx], gd = GGp[(uC + c) * 64 + dk]; S[(size_t)(uC + c) * 8192 + idx] = s; s = gd * s + uu; }
#pragma unroll 8
        for (int c = 0; c < 32; ++c) { const float uu = U[(size_t)(uL + c) * 8192 + idx], gd = GGp[(uL + c) * 64 + dk]; S[(size_t)(uL + c) * 8192 + idx] = s; s = gd * s + uu; }
    }
}
__device__ __forceinline__ void gla_g3_unit(KA a, LAS float* F, int l, int s, int h, int c, int tid) {
    const int lane = tid & 63, w = tid >> 6, r = lane & 31, hk = lane >> 5;
    const int nc = s < 4 ? 32 : 4;
    for (int dir = 0; dir < 2; ++dir) {
        const int cd = dir ? nc - 1 - c : c;
        gla_load_chunk(a, F, l, s, h, dir, cd, true, tid);
        for (int idx = tid; idx < 4096; idx += NTHR) { const int i = idx >> 6, d = idx & 63; const float cu = F[GL_CUM + i * 65 + d];
            F[GL_Q + i * 65 + d] *= expf(cu) * 0.125f; F[GL_K + i * 65 + d] *= expf(-cu); }
        __syncthreads();
        if (w < 4) { const int mi = w >> 1, nj = w & 1; f32x16 acc;
#pragma unroll
            for (int e = 0; e < 16; ++e) acc[e] = 0.f;
#pragma unroll 8
            for (int d0 = 0; d0 < 64; d0 += 2) { const float av = F[GL_Q + (32 * mi + r) * 65 + d0 + hk], bv = F[GL_K + (32 * nj + r) * 65 + d0 + hk]; acc = __builtin_amdgcn_mfma_f32_32x32x2f32(av, bv, acc, 0, 0, 0); }
#pragma unroll
            for (int e = 0; e < 16; ++e) { const int i = 32 * mi + (e & 3) + 8 * (e >> 2) + 4 * hk, j = 32 * nj + r; F[GL_AM + i * 65 + j] = (i >= j) ? acc[e] : 0.f; } }
        __syncthreads();
        { const float* Sg = (const float*)(a->ws + WS_GS) + (size_t)gla_uid(s, h, dir, cd) * 8192;
#pragma unroll
          for (int p = 0; p < 4; ++p) { const int idx = (tid + p * NTHR) * 4, dk = idx >> 7, dv = idx & 127; const f32x4 v = *(const f32x4*)(Sg + idx);
              F[GL_SST + dk * 129 + dv] = v[0]; F[GL_SST + dk * 129 + dv + 1] = v[1]; F[GL_SST + dk * 129 + dv + 2] = v[2]; F[GL_SST + dk * 129 + dv + 3] = v[3]; } }
        __syncthreads();
        { const int mi = w >> 2, nj = w & 3; f32x16 acc;
#pragma unroll
          for (int e = 0; e < 16; ++e) acc[e] = 0.f;
#pragma unroll 8
          for (int j0 = 0; j0 < 64; j0 += 2) { const float av = F[GL_AM + (32 * mi + r) * 65 + j0 + hk], bv = F[GL_V + (j0 + hk) * 129 + 32 * nj + r]; acc = __builtin_amdgcn_mfma_f32_32x32x2f32(av, bv, acc, 0, 0, 0); }
#pragma unroll 8
          for (int d0 = 0; d0 < 64; d0 += 2) { const float av = F[GL_Q + (32 * mi + r) * 65 + d0 + hk], bv = F[GL_SST + (d0 + hk) * 129 + 32 * nj + r]; acc = __builtin_amdgcn_mfma_f32_32x32x2f32(av, bv, acc, 0, 0, 0); }
#pragma unroll
          for (int e = 0; e < 16; ++e) { const int i = 32 * mi + (e & 3) + 8 * (e >> 2) + 4 * hk, p = dir ? 63 - i : i, col = 32 * nj + r;
              if (dir == 0) F[GL_OS + p * 129 + col] = acc[e]; else F[GL_OS + p * 129 + col] += acc[e]; } }
        __syncthreads();
    }
    { const f16* P = (const f16*)(a->ws + WS_P); f16* Y = (f16*)(a->ws + WS_YALL) + (size_t)1 * T * 512;
      const float g0 = a->in[10][l * 128 + lane], g1 = a->in[10][l * 128 + lane + 64];
#pragma unroll
      for (int rr = 0; rr < 8; ++rr) { const int p = w * 8 + rr; const int tok = gla_tok(s, 0, c, p);
          const float o0 = F[GL_OS + p * 129 + lane], o1 = F[GL_OS + p * 129 + lane + 64];
          const float ss = wave_sum(o0 * o0 + o1 * o1, lane), rinv = 1.f / sqrtf(ss * (1.f / 128.f) + RMS_EPS);
          const float r0 = (float)P[(size_t)tok * NMAIN + C_GR + h * 128 + lane], r1 = (float)P[(size_t)tok * NMAIN + C_GR + h * 128 + lane + 64];
          Y[(size_t)tok * 512 + h * 128 + lane] = (f16)(o0 * rinv * g0 * siluf(r0)); Y[(size_t)tok * 512 + h * 128 + lane + 64] = (f16)(o1 * rinv * g1 * siluf(r1)); } }
    __syncthreads();
}

__device__ __forceinline__ void na_unit(KA a, int l, int b, int h, bool lat, int r, int j, int qt, int lane) {
    const f16* P = (const f16*)(a->ws + WS_P);
    const f16* VT = (const f16*)(a->ws + WS_VTNA) + (size_t)(b * 512 + h * 128) * KVPOS;
    const int ql = lane & 15, g = lane >> 4;
    const int qtok = lat ? b * 2048 + r * 64 + j * 16 + ql : TL + b * 256 + qt * 16 + ql;
    f16x8 bq[4];
#pragma unroll
    for (int kk = 0; kk < 4; ++kk) bq[kk] = *(const f16x8*)(P + (size_t)qtok * NMAIN + C_NAQ + h * 128 + 32 * kk + 8 * g);
    f32x4 o[8];
#pragma unroll
    for (int dt = 0; dt < 8; ++dt) o[dt] = (f32x4){0.f, 0.f, 0.f, 0.f};
    float m = -1e30f, lsum = 0.f;
    const float scale = 0.08838834764831845f;
    const int row0 = min(max(r - 4, 0), 24), band0 = min(max(16 * j - 8, 0), 32), qcol = 16 * j + ql, wst = min(max(qcol - 8, 0), 48);
    const float* rpb = a->in[7] + (size_t)(l * 4 + h) * 15 * 31;
    const int nsteps = lat ? 16 : 8;
    for (int st = 0; st < nsteps; ++st) {
        const bool islat = lat && st < 8;
        int ktok0, pos0;
        if (islat) { const int kr = row0 + st; ktok0 = b * 2048 + kr * 64 + band0; pos0 = 256 + kr * 64 + band0; }
        else { const int cs = lat ? st - 8 : st; ktok0 = TL + b * 256 + cs * 32; pos0 = cs * 32; }
        const f16* kp0 = P + (size_t)(ktok0 + ql) * NMAIN + C_NAK + h * 128 + 8 * g; const f16* kp1 = kp0 + (size_t)16 * NMAIN;
        f32x4 s0 = (f32x4){0.f, 0.f, 0.f, 0.f}, s1 = (f32x4){0.f, 0.f, 0.f, 0.f};
#pragma unroll
        for (int kk = 0; kk < 4; ++kk) { const f16x8 k0 = *(const f16x8*)(kp0 + 32 * kk), k1 = *(const f16x8*)(kp1 + 32 * kk); s0 = mfma16(k0, bq[kk], s0); s1 = mfma16(k1, bq[kk], s1); }
        float sv[8];
#pragma unroll
        for (int i = 0; i < 4; ++i) { sv[i] = s0[i] * scale; sv[4 + i] = s1[i] * scale; }
        if (islat) { const int dr = row0 + st - r;
#pragma unroll
            for (int i = 0; i < 8; ++i) { const int kc = band0 + 4 * g + (i & 3) + 16 * (i >> 2), dc = kc - qcol; const bool ok = kc >= wst && kc < wst + 16;
                const float bias = rpb[(dr + 7) * 31 + min(max(dc + 15, 0), 30)]; sv[i] = ok ? sv[i] + bias : -1e30f; } }
        float mx = sv[0];
#pragma unroll
        for (int i = 1; i < 8; ++i) mx = fmaxf(mx, sv[i]);
        mx = fmaxf(mx, shx(mx, 16, lane)); mx = fmaxf(mx, shx(mx, 32, lane));
        const float mnew = fmaxf(m, mx), alpha = __expf(m - mnew); m = mnew;
        float ps = 0.f; float p[8];
#pragma unroll
        for (int i = 0; i < 8; ++i) { p[i] = __expf(sv[i] - mnew); ps += p[i]; }
        lsum = lsum * alpha + ps;
        f16x8 pb;
#pragma unroll
        for (int i = 0; i < 8; ++i) pb[i] = (f16)p[i];
#pragma unroll
        for (int dt = 0; dt < 8; ++dt) { const f16* vp = VT + (size_t)(16 * dt + ql) * KVPOS + pos0 + 4 * g;
            const f16x4 va = *(const f16x4*)vp, vb = *(const f16x4*)(vp + 16); f16x8 av;
            av[0] = va[0]; av[1] = va[1]; av[2] = va[2]; av[3] = va[3]; av[4] = vb[0]; av[5] = vb[1]; av[6] = vb[2]; av[7] = vb[3];
            o[dt] = mfma16(av, pb, o[dt] * alpha); }
    }
    lsum += shx(lsum, 16, lane); lsum += shx(lsum, 32, lane);
    const float inv = 1.f / lsum;
    f16* Y = (f16*)(a->ws + WS_YALL) + (size_t)qtok * 512 + h * 128 + 4 * g;
#pragma unroll
    for (int dt = 0; dt < 8; ++dt) { f16x4 ov; ov[0] = (f16)(o[dt][0] * inv); ov[1] = (f16)(o[dt][1] * inv); ov[2] = (f16)(o[dt][2] * inv); ov[3] = (f16)(o[dt][3] * inv); *(f16x4*)(Y + 16 * dt) = ov; }
}

__device__ __forceinline__ void diff_unit(KA a, int l, int b, int h, bool lat, int qt, float lam, float lam_init, int lane) {
    const int ql = lane & 15, g = lane >> 4;
    const int qtok = lat ? b * 2048 + qt * 16 + ql : TL + b * 256 + qt * 16 + ql;
    const f16* qrow = lat ? (const f16*)(a->ws + WS_DQ) + (size_t)qtok * 512 + h * 128 : (const f16*)(a->ws + WS_P) + (size_t)qtok * NMAIN + C_DQ + h * 128;
    f16x8 bq[2][2];
#pragma unroll
    for (int mm = 0; mm < 2; ++mm)
#pragma unroll
        for (int kk = 0; kk < 2; ++kk) bq[mm][kk] = *(const f16x8*)(qrow + mm * 64 + 32 * kk + 8 * g);
    const f16* KA = (const f16*)(a->ws + WS_KALL) + (size_t)b * KVPOS * 512 + h * 128 + 8 * g;
    const f16* VT = (const f16*)(a->ws + WS_VTDF) + (size_t)(b * 512 + h * 128) * KVPOS;
    f32x4 o1[8], o2[8];
#pragma unroll
    for (int dt = 0; dt < 8; ++dt) { o1[dt] = (f32x4){0.f, 0.f, 0.f, 0.f}; o2[dt] = (f32x4){0.f, 0.f, 0.f, 0.f}; }
    float m1 = -1e30f, m2 = -1e30f, l1 = 0.f, l2 = 0.f;
    const int nsteps = lat ? 72 : 8;
    for (int st = 0; st < nsteps; ++st) {
        const int pos0 = st * 32;
        const f16* kp0 = KA + (size_t)(pos0 + ql) * 512; const f16* kp1 = kp0 + 16 * 512;
        f32x4 sa0 = (f32x4){0.f, 0.f, 0.f, 0.f}, sa1 = sa0, sb0 = sa0, sb1 = sa0;
#pragma unroll
        for (int kk = 0; kk < 2; ++kk) {
            const f16x8 ka0 = *(const f16x8*)(kp0 + 32 * kk), ka1 = *(const f16x8*)(kp1 + 32 * kk), kb0 = *(const f16x8*)(kp0 + 64 + 32 * kk), kb1 = *(const f16x8*)(kp1 + 64 + 32 * kk);
            sa0 = mfma16(ka0, bq[0][kk], sa0); sa1 = mfma16(ka1, bq[0][kk], sa1); sb0 = mfma16(kb0, bq[1][kk], sb0); sb1 = mfma16(kb1, bq[1][kk], sb1); }
        float pa[8], pb2[8]; float mxa, mxb;
#pragma unroll
        for (int i = 0; i < 4; ++i) { pa[i] = sa0[i] * 0.125f; pa[4 + i] = sa1[i] * 0.125f; pb2[i] = sb0[i] * 0.125f; pb2[4 + i] = sb1[i] * 0.125f; }
        mxa = pa[0]; mxb = pb2[0];
#pragma unroll
        for (int i = 1; i < 8; ++i) { mxa = fmaxf(mxa, pa[i]); mxb = fmaxf(mxb, pb2[i]); }
        mxa = fmaxf(mxa, shx(mxa, 16, lane)); mxa = fmaxf(mxa, shx(mxa, 32, lane)); mxb = fmaxf(mxb, shx(mxb, 16, lane)); mxb = fmaxf(mxb, shx(mxb, 32, lane));
        const float n1 = fmaxf(m1, mxa), n2 = fmaxf(m2, mxb), al1 = __expf(m1 - n1), al2 = __expf(m2 - n2); m1 = n1; m2 = n2;
        float s1 = 0.f, s2 = 0.f; f16x8 p1, p2;
#pragma unroll
        for (int i = 0; i < 8; ++i) { const float e1 = __expf(pa[i] - n1), e2 = __expf(pb2[i] - n2); s1 += e1; s2 += e2; p1[i] = (f16)e1; p2[i] = (f16)e2; }
        l1 = l1 * al1 + s1; l2 = l2 * al2 + s2;
#pragma unroll
        for (int dt = 0; dt < 8; ++dt) { const f16* vp = VT + (size_t)(16 * dt + ql) * KVPOS + pos0 + 4 * g;
            const f16x4 va = *(const f16x4*)vp, vb = *(const f16x4*)(vp + 16); f16x8 av;
            av[0] = va[0]; av[1] = va[1]; av[2] = va[2]; av[3] = va[3]; av[4] = vb[0]; av[5] = vb[1]; av[6] = vb[2]; av[7] = vb[3];
            o1[dt] = mfma16(av, p1, o1[dt] * al1); o2[dt] = mfma16(av, p2, o2[dt] * al2); }
    }
    l1 += shx(l1, 16, lane); l1 += shx(l1, 32, lane); l2 += shx(l2, 16, lane); l2 += shx(l2, 32, lane);
    const float i1 = 1.f / l1, i2 = lam / l2;
    float ss = 0.f;
#pragma unroll
    for (int dt = 0; dt < 8; ++dt) { o1[dt] = o1[dt] * i1 - o2[dt] * i2; ss += (o1[dt][0] * o1[dt][0] + o1[dt][1] * o1[dt][1]) + (o1[dt][2] * o1[dt][2] + o1[dt][3] * o1[dt][3]); }
    ss += shx(ss, 16, lane); ss += shx(ss, 32, lane);
    const float rinv = (1.f - lam_init) / sqrtf(ss * (1.f / 128.f) + RMS_EPS);
    const float* gain = a->in[12] + l * 128 + 4 * g;
    f16* Y = (f16*)(a->ws + WS_YALL) + (size_t)3 * T * 512 + (size_t)qtok * 512 + h * 128 + 4 * g;
#pragma unroll
    for (int dt = 0; dt < 8; ++dt) { const f32x4 gv = *(const f32x4*)(gain + 16 * dt); f16x4 ov;
        ov[0] = (f16)(o1[dt][0] * rinv * gv[0]); ov[1] = (f16)(o1[dt][1] * rinv * gv[1]); ov[2] = (f16)(o1[dt][2] * rinv * gv[2]); ov[3] = (f16)(o1[dt][3] * rinv * gv[3]); *(f16x4*)(Y + 16 * dt) = ov; }
}
__device__ __forceinline__ void rope_row(KA a, int t, int lane) {
    const f16* P = (const f16*)(a->ws + WS_P) + (size_t)t * NMAIN;
    f16* KALL = (f16*)(a->ws + WS_KALL);
    if (t >= TL) { const int tt = t - TL, b = tt >> 8, p = tt & 255; *(f16x8*)(KALL + ((size_t)b * KVPOS + p) * 512 + 8 * lane) = *(const f16x8*)(P + C_DK + 8 * lane); return; }
    const int b = t >> 11, n = t & 2047, grow = n >> 6, gcol = n & 63;
    const int blk = lane >> 3, i0 = 2 * (lane & 7);
    f16* dq = (f16*)(a->ws + WS_DQ) + (size_t)t * 512; f16* dk = KALL + ((size_t)b * KVPOS + 256 + n) * 512;
#pragma unroll
    for (int half = 0; half < 2; ++half) {
        const float pos = (float)(half ? gcol : grow);
        float cs[2], sn[2];
#pragma unroll
        for (int e = 0; e < 2; ++e) { const float inv = powf(10000.f, -(float)(i0 + e) * (1.f / 16.f)); sincosf(pos * inv, &sn[e], &cs[e]); }
        const int off = blk * 64 + half * 32 + i0;
        { const f16x2 x1 = *(const f16x2*)(P + C_DQ + off), x2 = *(const f16x2*)(P + C_DQ + off + 16); f16x2 y1, y2;
#pragma unroll
          for (int e = 0; e < 2; ++e) { const float u1 = (float)x1[e], u2 = (float)x2[e]; y1[e] = (f16)(u1 * cs[e] - u2 * sn[e]); y2[e] = (f16)(u1 * sn[e] + u2 * cs[e]); }
          *(f16x2*)(dq + off) = y1; *(f16x2*)(dq + off + 16) = y2; }
        { const f16x2 x1 = *(const f16x2*)(P + C_DK + off), x2 = *(const f16x2*)(P + C_DK + off + 16); f16x2 y1, y2;
#pragma unroll
          for (int e = 0; e < 2; ++e) { const float u1 = (float)x1[e], u2 = (float)x2[e]; y1[e] = (f16)(u1 * cs[e] - u2 * sn[e]); y2[e] = (f16)(u1 * sn[e] + u2 * cs[e]); }
          *(f16x2*)(dk + off) = y1; *(f16x2*)(dk + off + 16) = y2; }
    }
}

struct FnetSched {
    int G, c;
    __device__ __forceinline__ bool next(int i, pg8::Unit& u) const { const int L = i * G + c; if (L >= 256) return false;
        const int sp = L & 3, nt2 = (L >> 2) & 1, mt = (L >> 3) & 7, b = L >> 6; u.pm = mt; u.pn = b * 2 + nt2; u.kt0 = sp * 16; u.tag = b * 4 + sp; return true; }
    __device__ __forceinline__ void a_ready(const pg8::Unit&) const {}
    __device__ __forceinline__ void done(const pg8::Unit&) const {}
};
struct EpiFnetPart {
    static constexpr bool PERM = true, AFTER_DRAIN = false;
    float* FP;
    __device__ __forceinline__ void operator()(const f32x4 (&acc)[2][2][4][2], const pg8::Unit& u, int wr, int wc, int fr, int fq) const {
        const int b = u.tag >> 2, sp = u.tag & 3;
        const int row0 = b * 2048 + u.pm * 256 + wr * 64 + fr, col0 = (u.pn & 1) * 256 + wc * 32 + 8 * fq;
        float* base = FP + (size_t)sp * TL * 512;
#pragma unroll
        for (int ai = 0; ai < 2; ++ai)
#pragma unroll
            for (int m = 0; m < 4; ++m) { float* rowp = base + (size_t)(row0 + ai * 128 + m * 16) * 512 + col0;
#pragma unroll
                for (int bj = 0; bj < 2; ++bj) { *(f32x4*)(rowp + bj * 128) = acc[ai][bj][m][0]; *(f32x4*)(rowp + bj * 128 + 4) = acc[ai][bj][m][1]; } }
    }
};
struct FnetCtxSched {
    int G, c;
    __device__ __forceinline__ bool next(int i, pg8::Unit& u) const { const int L = i * G + c; if (L >= 8) return false; u.pm = 0; u.pn = L; u.kt0 = 0; u.tag = L >> 1; return true; }
    __device__ __forceinline__ void a_ready(const pg8::Unit&) const {}
    __device__ __forceinline__ void done(const pg8::Unit&) const {}
};
struct EpiFnetCtx {
    static constexpr bool PERM = true, AFTER_DRAIN = false;
    f16* Y;
    __device__ __forceinline__ void operator()(const f32x4 (&acc)[2][2][4][2], const pg8::Unit& u, int wr, int wc, int fr, int fq) const {
        const int row0 = TL + u.tag * 256 + wr * 64 + fr, col0 = (u.pn & 1) * 256 + wc * 32 + 8 * fq;
#pragma unroll
        for (int ai = 0; ai < 2; ++ai)
#pragma unroll
            for (int m = 0; m < 4; ++m) { f16* rowp = Y + (size_t)(row0 + ai * 128 + m * 16) * 512 + col0;
#pragma unroll
                for (int bj = 0; bj < 2; ++bj) *(f16x8*)(rowp + bj * 128) = pack8(acc[ai][bj][m][0], acc[ai][bj][m][1]); }
    }
};
struct Merge1Sched {
    int G, c, nM;
    __device__ __forceinline__ bool next(int i, pg8::Unit& u) const { const int tix = (i >> 2) * G + c, g = i & 3; if (tix >= nM * 8) return false; int pm, pn; pg8::tile_of(tix, nM, 8, pm, pn);
        u.pm = g * 36 + pm; u.pn = g * 8 + pn; u.kt0 = 0; u.tag = g; return true; }
    __device__ __forceinline__ void a_ready(const pg8::Unit&) const {}
    __device__ __forceinline__ void done(const pg8::Unit&) const {}
};
struct EpiMerge1 {
    static constexpr bool PERM = true, AFTER_DRAIN = false;
    const f16* P; float* S32; f16* S16;
    __device__ __forceinline__ void operator()(const f32x4 (&acc)[2][2][4][2], const pg8::Unit& u, int wr, int wc, int fr, int fq) const {
        const int g = u.tag, row0 = (u.pm - g * 36) * 256 + wr * 64 + fr, col0 = (u.pn - g * 8) * 256 + wc * 32 + 8 * fq;
#pragma unroll
        for (int ai = 0; ai < 2; ++ai)
#pragma unroll
            for (int m = 0; m < 4; ++m) { const int row = row0 + ai * 128 + m * 16;
#pragma unroll
                for (int bj = 0; bj < 2; ++bj) { const int col = col0 + bj * 128;
                    const f16x8 gt = *(const f16x8*)(P + (size_t)row * NMAIN + C_GATE + g * 2048 + col);
                    f32x4 v0 = acc[ai][bj][m][0], v1 = acc[ai][bj][m][1];
#pragma unroll
                    for (int e = 0; e < 4; ++e) { v0[e] *= sigmf((float)gt[e]); v1[e] *= sigmf((float)gt[4 + e]); }
                    float* sp = S32 + (size_t)row * D + col;
                    if (g > 0) { v0 += *(const f32x4*)sp; v1 += *(const f32x4*)(sp + 4); }
                    if (g < 3) { *(f32x4*)sp = v0; *(f32x4*)(sp + 4) = v1; }
                    else *(f16x8*)(S16 + (size_t)row * D + col) = pack8(v0, v1); } }
    }
};
struct EpiMerge2 {
    static constexpr bool PERM = true, AFTER_DRAIN = false;
    const float* res_lat; const float* res_ctx; const float* mod; float* V1; int l;
    __device__ __forceinline__ void operator()(const f32x4 (&acc)[2][2][4][2], const pg8::Unit& u, int wr, int wc, int fr, int fq) const {
        const int row0 = u.pm * 256 + wr * 64 + fr, col0 = u.pn * 256 + wc * 32 + 8 * fq;
        const int br = brow_of(u.pm * 256);
        const float* gate = mod + ((size_t)(l * 5 + br) * 6 + 2) * D;
#pragma unroll
        for (int ai = 0; ai < 2; ++ai)
#pragma unroll
            for (int m = 0; m < 4; ++m) { const int row = row0 + ai * 128 + m * 16;
                const float* rs = row < TL ? res_lat + (size_t)row * D : res_ctx + (size_t)(row - TL) * D;
#pragma unroll
                for (int bj = 0; bj < 2; ++bj) { const int col = col0 + bj * 128;
                    const f32x4 g0 = *(const f32x4*)(gate + col), g1 = *(const f32x4*)(gate + col + 4), x0 = *(const f32x4*)(rs + col), x1 = *(const f32x4*)(rs + col + 4);
                    *(f32x4*)(V1 + (size_t)row * D + col) = x0 * ALPHA + g0 * acc[ai][bj][m][0]; *(f32x4*)(V1 + (size_t)row * D + col + 4) = x1 * ALPHA + g1 * acc[ai][bj][m][1]; } }
    }
};
template <int NC> struct MoeSched {
    int G, c; const int* tb;
    __device__ __forceinline__ bool next(int i, pg8::Unit& u) const { const int L = i * G + c; const int ntile = tb[33]; if (L >= ntile * NC) return false; const int rt = L / NC, pn = L % NC; const int e = tb[64 + rt];
        u.pm = rt; u.pn = e * NC + pn; u.kt0 = 0; u.tag = pn; return true; }
    __device__ __forceinline__ void a_ready(const pg8::Unit&) const {}
    __device__ __forceinline__ void done(const pg8::Unit&) const {}
};
struct EpiMoe1 {
    static constexpr bool PERM = true, AFTER_DRAIN = false;
    const float* slotw; f16* ACT;
    __device__ __forceinline__ void operator()(const f32x4 (&acc)[2][2][4][2], const pg8::Unit& u, int wr, int wc, int fr, int fq) const {
        const int row0 = u.pm * 256 + wr * 64 + fr, col0 = u.tag * 128 + wc * 32 + 8 * fq;
#pragma unroll
        for (int ai = 0; ai < 2; ++ai)
#pragma unroll
            for (int m = 0; m < 4; ++m) { const int row = row0 + ai * 128 + m * 16; const float w = slotw[row];
                f32x4 v0, v1;
#pragma unroll
                for (int e = 0; e < 4; ++e) { v0[e] = siluf(acc[ai][0][m][0][e]) * acc[ai][1][m][0][e] * w; v1[e] = siluf(acc[ai][0][m][1][e]) * acc[ai][1][m][1][e] * w; }
                *(f16x8*)(ACT + (size_t)row * 512 + col0) = pack8(v0, v1); }
    }
};
struct EpiMoe2 {
    static constexpr bool PERM = true, AFTER_DRAIN = false;
    f16* SOUT;
    __device__ __forceinline__ void operator()(const f32x4 (&acc)[2][2][4][2], const pg8::Unit& u, int wr, int wc, int fr, int fq) const {
        const int row0 = u.pm * 256 + wr * 64 + fr, col0 = u.tag * 256 + wc * 32 + 8 * fq;
#pragma unroll
        for (int ai = 0; ai < 2; ++ai)
#pragma unroll
            for (int m = 0; m < 4; ++m) { f16* rowp = SOUT + (size_t)(row0 + ai * 128 + m * 16) * D + col0;
#pragma unroll
                for (int bj = 0; bj < 2; ++bj) *(f16x8*)(rowp + bj * 128) = pack8(acc[ai][bj][m][0], acc[ai][bj][m][1]); }
    }
};
__device__ __forceinline__ void moe_tables(KA a, LAS unsigned char* lds, int l, int tid) {
    LAS int* tb = (LAS int*)(lds + TBL_OFF);
    if (tid == 0) { const gu32* cnt = (const gu32*)(a->ws + WS_CTL) + CW_CNT + 32 * l; int base = 0, nt = 0;
        for (int e = 0; e < 32; ++e) { const int ce = (int)__hip_atomic_load(cnt + e, RLX_AGENT); tb[e] = base; const int k = (ce + 255) >> 8; for (int q = 0; q < k; ++q) tb[64 + nt + q] = e; nt += k; base += k * 256; }
        tb[32] = base; tb[33] = nt; }
    __syncthreads();
}

__device__ __forceinline__ void ph_ln_route(KA a, LAS unsigned char* lds, int l, int ntok, int tid, int bid, int G) {
    const int lane = tid & 63, wave = tid >> 6;
    LAS float* hs = (LAS float*)lds;
    LAS float* lg = (LAS float*)(lds + 16 * 2050 * 4);
    const float* V1 = (const float*)(a->ws + WS_S32); float* XL = (float*)(a->ws + WS_XL); f16* H = (f16*)(a->ws + WS_H);
    const float* g1 = a->in[15] + l * D; const float* b1 = a->in[16] + l * D;
    const float* wgp = a->in[19] + (size_t)l * D * 4; const float* wrt = a->in[21] + (size_t)l * 4 * D * 8;
    int* tok_e = (int*)(a->ws + WS_ROUT); float* tok_w = (float*)(a->ws + WS_ROUT) + 2 * T; int* tok_rank = (int*)(a->ws + WS_ROUT) + 4 * T;
    gu32* cnt = (gu32*)(a->ws + WS_CTL) + CW_CNT + 32 * l;
    for (int u = bid; u < ntok / 16; u += G) {
#pragma unroll 1
        for (int q = 0; q < 2; ++q) { const int tl = wave * 2 + q, t = u * 16 + tl;
            f32x4 v[8]; row_load(V1 + (size_t)t * D, lane, v); row_ln(v, lane);
#pragma unroll
            for (int j = 0; j < 8; ++j) { const int c = 4 * (lane + 64 * j); v[j] = v[j] * *(const f32x4*)(g1 + c) + *(const f32x4*)(b1 + c); *(f32x4*)(XL + (size_t)t * D + c) = v[j]; }
            row_ln(v, lane);
            const int br = brow_of(t); const float* sh = mod_vec(a, l, br, 3); const float* sc = mod_vec(a, l, br, 4);
#pragma unroll
            for (int j = 0; j < 8; ++j) { const int c = 4 * (lane + 64 * j); const f32x4 y = v[j] * (*(const f32x4*)(sc + c) + 1.f) + *(const f32x4*)(sh + c);
                f16x4 o; o[0] = (f16)y[0]; o[1] = (f16)y[1]; o[2] = (f16)y[2]; o[3] = (f16)y[3]; *(f16x4*)(H + (size_t)t * D + c) = o;
                hs[tl * 2050 + c] = y[0]; hs[tl * 2050 + c + 1] = y[1]; hs[tl * 2050 + c + 2] = y[2]; hs[tl * 2050 + c + 3] = y[3]; } }
        __syncthreads();
        f32x4 acc[3];
#pragma unroll
        for (int n = 0; n < 3; ++n) acc[n] = (f32x4){0.f, 0.f, 0.f, 0.f};
        { const int ti = lane & 15, kq = lane >> 4;
#pragma unroll 2
          for (int kk = 0; kk < 64; ++kk) { const int k = wave * 256 + kk * 4 + kq; const float av = hs[ti * 2050 + k];
              const float b0 = ti < 4 ? wgp[(size_t)k * 4 + ti] : wrt[((size_t)((ti - 4) >> 3) * D + k) * 8 + ((ti - 4) & 7)];
              const int n1 = 16 + ti - 4; const float b1v = wrt[((size_t)(n1 >> 3) * D + k) * 8 + (n1 & 7)];
              const int n2 = 32 + ti - 4; const float b2v = ti < 4 ? wrt[((size_t)(n2 >> 3) * D + k) * 8 + (n2 & 7)] : 0.f;
              acc[0] = __builtin_amdgcn_mfma_f32_16x16x4f32(av, b0, acc[0], 0, 0, 0); acc[1] = __builtin_amdgcn_mfma_f32_16x16x4f32(av, b1v, acc[1], 0, 0, 0); acc[2] = __builtin_amdgcn_mfma_f32_16x16x4f32(av, b2v, acc[2], 0, 0, 0); } }
        __syncthreads();
        { const int n = lane & 15, tq = lane >> 4;
#pragma unroll
          for (int nt = 0; nt < 3; ++nt)
#pragma unroll
              for (int e = 0; e < 4; ++e) hs[(wave * 16 + 4 * tq + e) * 48 + nt * 16 + n] = acc[nt][e]; }
        __syncthreads();
        for (int o = tid; o < 16 * 48; o += NTHR) { const int tl = o / 48, n = o % 48; float s = 0.f;
#pragma unroll
            for (int w2 = 0; w2 < 8; ++w2) s += hs[(w2 * 16 + tl) * 48 + n];
            if (n < 4) s += a->in[20][l * 4 + n]; else if (n < 36) s += a->in[22][l * 32 + (n - 4)];
            lg[tl * 48 + n] = s; }
        __syncthreads();
        if (tid < 16) { const int t = u * 16 + tid; const LAS float* L = lg + tid * 48;
            int gs = 0; float gm = L[0];
#pragma unroll
            for (int g = 1; g < 4; ++g) if (L[g] > gm) { gm = L[g]; gs = g; }
            float den = 0.f;
#pragma unroll
            for (int g = 0; g < 4; ++g) den += expf(L[g] - gm);
            const float gw = 1.f / den;
            const LAS float* E = L + 4 + gs * 8;
            int i0 = 0; float v0 = E[0];
#pragma unroll
            for (int e = 1; e < 8; ++e) if (E[e] > v0) { v0 = E[e]; i0 = e; }
            int i1 = -1; float v1 = -3.0e38f;
#pragma unroll
            for (int e = 0; e < 8; ++e) if (e != i0 && E[e] > v1) { v1 = E[e]; i1 = e; }
            const float ex = expf(v1 - v0), w0 = gw / (1.f + ex), w1 = gw * ex / (1.f + ex);
            const int e0 = gs * 8 + i0, e1 = gs * 8 + i1;
            const int r0 = (int)__hip_atomic_fetch_add(cnt + e0, 1u, RLX_AGENT), r1 = (int)__hip_atomic_fetch_add(cnt + e1, 1u, RLX_AGENT);
            tok_e[2 * t] = e0; tok_e[2 * t + 1] = e1; tok_w[2 * t] = w0; tok_w[2 * t + 1] = w1; tok_rank[2 * t] = r0; tok_rank[2 * t + 1] = r1; }
        __syncthreads();
    }
}
__device__ __forceinline__ void ph_scatter(KA a, LAS unsigned char* lds, int l, int ntok, int tid, int bid, int G) {
    moe_tables(a, lds, l, tid);
    const LAS int* tb = (const LAS int*)(lds + TBL_OFF);
    if (bid == 0 && tid < 192) ((int*)(a->ws + WS_TILES))[tid] = tb[tid];
    const int lane = tid & 63, wave = tid >> 6;
    const int* tok_e = (const int*)(a->ws + WS_ROUT); const float* tok_w = (const float*)(a->ws + WS_ROUT) + 2 * T; const int* tok_rank = (const int*)(a->ws + WS_ROUT) + 4 * T; int* tok_slot = (int*)(a->ws + WS_ROUT) + 6 * T;
    float* slotw = (float*)(a->ws + WS_SLOTW); const f16* H = (const f16*)(a->ws + WS_H); f16* AS = (f16*)(a->ws + WS_ASORT);
    for (int t = bid * NWAVES + wave; t < ntok; t += G * NWAVES) {
        const u32x4* src = (const u32x4*)(H + (size_t)t * D);
        u32x4 v[4];
#pragma unroll
        for (int j = 0; j < 4; ++j) v[j] = src[lane + 64 * j];
#pragma unroll
        for (int k = 0; k < 2; ++k) { const int slot = tb[tok_e[2 * t + k]] + tok_rank[2 * t + k];
            u32x4* dst = (u32x4*)(AS + (size_t)slot * D);
#pragma unroll
            for (int j = 0; j < 4; ++j) dst[lane + 64 * j] = v[j];
            if (lane == 0) { slotw[slot] = tok_w[2 * t + k]; tok_slot[2 * t + k] = slot; } }
    }
}
#define SB0() __builtin_amdgcn_sched_barrier(0)
__device__ __forceinline__ void ph_final(KA a, int l, int ntok, int tid, int bid, int G) {
    const int lane = tid & 63, wave = __builtin_amdgcn_readfirstlane(tid >> 6);
    const int* tok_slot = (const int*)(a->ws + WS_ROUT) + 6 * T; const f16* SOUT = (const f16*)(a->ws + WS_SOUT);
    float* XL = (float*)(a->ws + WS_XL); f16* H = (f16*)(a->ws + WS_H);
    const float* g2 = a->in[17] + l * D; const float* b2 = a->in[18] + l * D;
    for (int t = bid * NWAVES + wave; t < ntok; t += G * NWAVES) {
        const int s0 = __builtin_amdgcn_readfirstlane(tok_slot[2 * t]), s1 = __builtin_amdgcn_readfirstlane(tok_slot[2 * t + 1]); const int br = brow_of(t);
        const float* gate = mod_vec(a, l, br, 5) + 4 * lane; const float* xr = XL + (size_t)t * D + 4 * lane;
        const f16* fa = SOUT + (size_t)s0 * D + 4 * lane; const f16* fb = SOUT + (size_t)s1 * D + 4 * lane;
        f32x4 v[8];
#pragma unroll
        for (int jj = 0; jj < 8; jj += 2) {
#pragma unroll
            for (int j = jj; j < jj + 2; ++j) { const f32x4 x = *(const f32x4*)(xr + 256 * j); const f16x4 ya = *(const f16x4*)(fa + 256 * j), yb = *(const f16x4*)(fb + 256 * j); const f32x4 gt = *(const f32x4*)(gate + 256 * j);
                f32x4 f; f[0] = (float)ya[0] + (float)yb[0]; f[1] = (float)ya[1] + (float)yb[1]; f[2] = (float)ya[2] + (float)yb[2]; f[3] = (float)ya[3] + (float)yb[3];
                v[j] = x * ALPHA + gt * f; }
            SB0();
        }
        row_ln(v, lane);
        SB0();
        const float* g2p = g2 + 4 * lane; const float* b2p = b2 + 4 * lane;
#pragma unroll
        for (int jj = 0; jj < 8; jj += 4) {
#pragma unroll
            for (int j = jj; j < jj + 4; ++j) v[j] = v[j] * *(const f32x4*)(g2p + 256 * j) + *(const f32x4*)(b2p + 256 * j);
            SB0();
        }
        if (l == 1) {
            float* op = a->out + (size_t)t * D + 4 * lane;
#pragma unroll
            for (int j = 0; j < 8; ++j) *(f32x4*)(op + 256 * j) = v[j];
        } else {
            float* op = XL + (size_t)t * D + 4 * lane;
#pragma unroll
            for (int j = 0; j < 8; ++j) *(f32x4*)(op + 256 * j) = v[j];
            SB0();
            row_ln(v, lane);
            SB0();
            const float* sh = mod_vec(a, l + 1, br, 0) + 4 * lane; const float* sc = mod_vec(a, l + 1, br, 1) + 4 * lane; f16* hp = H + (size_t)t * D + 4 * lane;
#pragma unroll
            for (int jj = 0; jj < 8; jj += 4) {
#pragma unroll
                for (int j = jj; j < jj + 4; ++j) { const f32x4 y = v[j] * (*(const f32x4*)(sc + 256 * j) + 1.f) + *(const f32x4*)(sh + 256 * j);
                    f16x4 o; o[0] = (f16)y[0]; o[1] = (f16)y[1]; o[2] = (f16)y[2]; o[3] = (f16)y[3]; *(f16x4*)(hp + 256 * j) = o; }
                SB0();
            }
        }
        SB0();
    }
}

#ifndef PHASE_ATTR
#define PHASE_ATTR __forceinline__
#endif
#define PH_PROLOG int tid_ = threadIdx.x, bid_ = blockIdx.x; asm volatile("" : "+v"(tid_), "+s"(bid_), "+s"(a)); const int tid = tid_, bid = bid_, G = gridDim.x, lane = tid & 63, wave = __builtin_amdgcn_readfirstlane(tid >> 6); const int gw = bid * NWAVES + wave, NGW = G * NWAVES; (void)lane; (void)gw; (void)NGW;
__device__ PHASE_ATTR void P_mod_tables(KA a, LAS unsigned char* lds) { PH_PROLOG ph_mod_tables(a, lds, tid, bid, G); }
__device__ PHASE_ATTR void P_convert(KA a, LAS unsigned char* lds) { PH_PROLOG ph_convert(a, lds, tid, bid, G); }
__device__ PHASE_ATTR void P_inproj(KA a, LAS unsigned char* lds, int l) {
    PH_PROLOG
    pg8::Gemm g{a->ws, a->ws, 2048, 32}; InProjSched S{G, bid, l}; EpiInProj E{a->ws, WT0 + WT_STRIDE * l};
    pg8::gemm_phase<EpiInProj, InProjSched, true, true>(lds + RING_OFF, g, S, E);
}
__device__ PHASE_ATTR void P_gla1(KA a, LAS unsigned char* lds, int l) {
    PH_PROLOG
    LAS float* F = (LAS float*)lds;
    for (int u = bid; u < 1152; u += G) {
        int s, h, dir, c;
        if (u < 1024) { s = u >> 8; h = (u >> 6) & 3; dir = (u >> 5) & 1; c = u & 31; } else { const int v = u - 1024; s = 4 + (v >> 5); h = (v >> 3) & 3; dir = (v >> 2) & 1; c = v & 3; }
        gla_g1_unit(a, F, l, s, h, dir, c, tid);
    }
}
__device__ PHASE_ATTR void P_na_rope(KA a, int l) {
    PH_PROLOG
    for (int u = gw; u < 2048; u += NGW) na_unit(a, l, u >> 9, (u >> 7) & 3, true, (u >> 2) & 31, u & 3, 0, lane);
    if (l == 0) for (int u = gw; u < 256; u += NGW) na_unit(a, l, u >> 6, (u >> 4) & 3, false, 0, 0, u & 15, lane);
    for (int t = gw; t < T; t += NGW) rope_row(a, t, lane);
}
__device__ PHASE_ATTR void P_fnet2(KA a, LAS unsigned char* lds) {
    PH_PROLOG
    pg8::Gemm g{a->ws + WS_TBLL, a->ws + WS_FTL, 4096, 16}; FnetSched S{G, bid}; EpiFnetPart E{(float*)(a->ws + WS_FP)};
    pg8::gemm_phase<EpiFnetPart, FnetSched, true, true>(lds + RING_OFF, g, S, E);
}
__device__ PHASE_ATTR void P_fnet2c(KA a, LAS unsigned char* lds) {
    PH_PROLOG
    pg8::Gemm g{a->ws + WS_TBLC, a->ws + WS_FTC, 512, 8}; FnetCtxSched S{G, bid}; EpiFnetCtx E{(f16*)(a->ws + WS_YALL) + (size_t)2 * T * 512};
    pg8::gemm_phase<EpiFnetCtx, FnetCtxSched, true, true>(lds + RING_OFF, g, S, E);
}
__device__ PHASE_ATTR void P_scan_diff(KA a, int l) {
    PH_PROLOG
    gla_scan(a, tid, bid, G);
    const float lam_init = 0.8f - 0.6f * expf(-0.3f * (float)l);
    const float* dl = a->in[11] + l * 256;
    const float lam = expf(wave_sum(dl[lane] * dl[64 + lane], lane)) - expf(wave_sum(dl[128 + lane] * dl[192 + lane], lane)) + lam_init;
    for (int u = gw; u < 2048; u += NGW) diff_unit(a, l, u >> 9, (u >> 7) & 3, true, u & 127, lam, lam_init, lane);
    if (l == 0) for (int u = gw; u < 256; u += NGW) diff_unit(a, l, u >> 6, (u >> 4) & 3, false, u & 15, lam, lam_init, lane);
}
__device__ PHASE_ATTR void P_gla3(KA a, LAS unsigned char* lds, int l) {
    PH_PROLOG
    LAS float* F = (LAS float*)lds;
    const int ng3 = (l == 0) ? 576 : 512;
    for (int u = bid; u < ng3; u += G) {
        int s, h, c;
        if (u < 512) { s = u >> 7; h = (u >> 5) & 3; c = u & 31; } else { const int v = u - 512; s = 4 + (v >> 4); h = (v >> 2) & 3; c = v & 3; }
        gla_g3_unit(a, F, l, s, h, c, tid);
    }
    const float* FP = (const float*)(a->ws + WS_FP); f16* Y2 = (f16*)(a->ws + WS_YALL) + (size_t)2 * T * 512;
    for (int t = gw; t < TL; t += NGW) {
        f32x4 s0 = (f32x4){0.f, 0.f, 0.f, 0.f}, s1 = s0;
#pragma unroll
        for (int sp = 0; sp < 4; ++sp) { const float* p = FP + ((size_t)sp * TL + t) * 512 + 8 * lane; s0 += *(const f32x4*)p; s1 += *(const f32x4*)(p + 4); }
        *(f16x8*)(Y2 + (size_t)t * 512 + 8 * lane) = pack8(s0, s1);
    }
}
__device__ PHASE_ATTR void P_merge1(KA a, LAS unsigned char* lds, int l) {
    PH_PROLOG
    pg8::Gemm g{a->ws + WS_YALL, a->ws + WS_WBR + (size_t)l * 4 * D * 512 * 2, 512, 8}; Merge1Sched S{G, bid, (l == 0) ? 36 : 32};
    EpiMerge1 E{(const f16*)(a->ws + WS_P), (float*)(a->ws + WS_S32), (f16*)(a->ws + WS_S16)};
    pg8::gemm_phase<EpiMerge1, Merge1Sched, true, true>(lds + RING_OFF, g, S, E);
}
__device__ PHASE_ATTR void P_merge2(KA a, LAS unsigned char* lds, int l) {
    PH_PROLOG
    pg8::Gemm g{a->ws + WS_S16, a->ws + WS_WOUT + (size_t)l * D * D * 2, 2048, 32}; Merge2Sched S{G, bid, (l == 0) ? 36 : 32};
    const float* XLc = (const float*)(a->ws + WS_XL);
    EpiMerge2 E{l == 0 ? a->in[0] : XLc, l == 0 ? a->in[2] : XLc + (size_t)TL * D, (const float*)(a->ws + WS_MOD), (float*)(a->ws + WS_S32), l};
    pg8::gemm_phase<EpiMerge2, Merge2Sched, true, true>(lds + RING_OFF, g, S, E);
}
__device__ PHASE_ATTR void P_ln_route(KA a, LAS unsigned char* lds, int l) { PH_PROLOG ph_ln_route(a, lds, l, l == 0 ? T : TL, tid, bid, G); }
__device__ PHASE_ATTR void P_scatter(KA a, LAS unsigned char* lds, int l) { PH_PROLOG ph_scatter(a, lds, l, l == 0 ? T : TL, tid, bid, G); }
__device__ PHASE_ATTR void P_moe1(KA a, LAS unsigned char* lds, int l) {
    PH_PROLOG
    pg8::Gemm g{a->ws + WS_ASORT, a->ws + WS_WGU + (size_t)l * 32 * 1024 * D * 2, 2048, 32}; MoeSched<4> S{G, bid, (const int*)(a->ws + WS_TILES)};
    EpiMoe1 E{(const float*)(a->ws + WS_SLOTW), (f16*)(a->ws + WS_ACT)};
    pg8::gemm_phase<EpiMoe1, MoeSched<4>, true, true>(lds + RING_OFF, g, S, E);
}
__device__ PHASE_ATTR void P_moe2(KA a, LAS unsigned char* lds, int l) {
    PH_PROLOG
    pg8::Gemm g{a->ws + WS_ACT, a->ws + WS_WDN + (size_t)l * 32 * D * 512 * 2, 512, 8}; MoeSched<8> S{G, bid, (const int*)(a->ws + WS_TILES)};
    EpiMoe2 E{(f16*)(a->ws + WS_SOUT)};
    pg8::gemm_phase<EpiMoe2, MoeSched<8>, true, true>(lds + RING_OFF, g, S, E);
}
__device__ PHASE_ATTR void P_final(KA a, int l) { PH_PROLOG ph_final(a, l, l == 0 ? T : TL, tid, bid, G); }

#ifndef PH_MASK
#define PH_MASK 0xFFFF
#endif
#define EN(j) (((PH_MASK) >> (j)) & 1)
__global__ void __launch_bounds__(NTHR, 2) mk_fwd(Args args) {
    extern __shared__ __attribute__((aligned(16))) unsigned char lds_raw[];
    LAS unsigned char* lds = (LAS unsigned char*)lds_raw;
    KA a = (KA)__builtin_amdgcn_kernarg_segment_ptr();
    volatile LAS unsigned* MISC = (volatile LAS unsigned*)(lds + MISC_OFF);
    if (threadIdx.x < 128) MISC[threadIdx.x] = 0u;
    __syncthreads();
#if ONE_LAUNCH
    (void)xcd_barrier_post((unsigned*)(a->ws + WS_CTL) + CW_BAR, MISC + 8);
#endif
    const int lo = args.ph_lo, hi = args.ph_hi;
#define IN(k) (lo <= (k) && (k) < hi)
#define SEAM(k) do { if (IN(k) && IN((k) + 1)) { XcdBarrier bar; bar.bar = (unsigned*)(a->ws + WS_CTL) + CW_BAR; bar.x = xb_xcc_id(); bar.st = (volatile LAS unsigned*)(lds + MISC_OFF) + 8; xcd_barrier(bar); } } while (0)
    if (EN(0) && IN(0)) P_mod_tables(a, lds);
    SEAM(0);
    if (EN(1) && IN(1)) P_convert(a, lds);
    SEAM(1);
#define LAYER_BODY(l) { \
        const int pb = 2 + 11 * l; \
        if (EN(2) && IN(pb + 0)) P_inproj(a, lds, l); \
        SEAM(pb + 0); \
        if (EN(3) && IN(pb + 1)) { P_gla1(a, lds, l); P_na_rope(a, l); } \
        SEAM(pb + 1); \
        if (EN(4) && IN(pb + 2)) { P_fnet2(a, lds); if (l == 0) P_fnet2c(a, lds); P_scan_diff(a, l); } \
        SEAM(pb + 2); \
        if (EN(5) && IN(pb + 3)) P_gla3(a, lds, l); \
        SEAM(pb + 3); \
        if (EN(6) && IN(pb + 4)) P_merge1(a, lds, l); \
        SEAM(pb + 4); \
        if (EN(7) && IN(pb + 5)) P_merge2(a, lds, l); \
        SEAM(pb + 5); \
        if (EN(8) && IN(pb + 6)) P_ln_route(a, lds, l); \
        SEAM(pb + 6); \
        if (EN(9) && IN(pb + 7)) P_scatter(a, lds, l); \
        SEAM(pb + 7); \
        if (EN(10) && IN(pb + 8)) P_moe1(a, lds, l); \
        SEAM(pb + 8); \
        if (EN(11) && IN(pb + 9)) P_moe2(a, lds, l); \
        SEAM(pb + 9); \
        if (EN(12) && IN(pb + 10)) P_final(a, l); \
        SEAM(pb + 10); \
    }
    LAYER_BODY(0)
    LAYER_BODY(1)
#undef LAYER_BODY
#undef IN
#undef SEAM
}

extern "C" void kernel_launch(void* const* d_in, const int* in_sizes, int n_in, void* d_out, int out_size, void* d_ws, size_t ws_size, hipStream_t stream) {
    static int grid = 0;
    if (grid == 0) {
        if (n_in != 25 || out_size != TL * D || ws_size < WS_END) { fprintf(stderr, "kernel_launch: unexpected shapes (n_in %d, out %d, ws %zu); nothing launched\n", n_in, out_size, ws_size); grid = -1; return; }
        int dev = 0, cus = 0, per_cu = 0;
        if (hipGetDevice(&dev) != hipSuccess || hipDeviceGetAttribute(&cus, hipDeviceAttributeMultiprocessorCount, dev) != hipSuccess) { grid = -1; return; }
        if (hipFuncSetAttribute((const void*)mk_fwd, hipFuncAttributeMaxDynamicSharedMemorySize, LDS_BYTES) != hipSuccess) { fprintf(stderr, "kernel_launch: hipFuncSetAttribute failed\n"); grid = -1; return; }
        if (hipOccupancyMaxActiveBlocksPerMultiprocessor(&per_cu, (const void*)mk_fwd, NTHR, LDS_BYTES) != hipSuccess || per_cu < 1) fprintf(stderr, "kernel_launch: occupancy query says %d\n", per_cu);
        (void)hipGetLastError();
        grid = cus;
    }
    if (grid < 0) return;
    if (hipMemsetAsync((char*)d_ws + WS_CTL, 0, CTL_ZERO_BYTES, stream) != hipSuccess) return;
    Args a; memset(&a, 0, sizeof(a));
    for (int i = 0; i < 25; ++i) a.in[i] = (const float*)d_in[i];
    a.out = (float*)d_out; a.ws = (unsigned char*)d_ws;
#if ONE_LAUNCH
    a.ph_lo = 0; a.ph_hi = N_PHASES;
    hipLaunchKernelGGL(mk_fwd, dim3(grid), dim3(NTHR), LDS_BYTES, stream, a);
#else
    for (int k = 0; k < N_PHASES; ++k) { a.ph_lo = k; a.ph_hi = k + 1; hipLaunchKernelGGL(mk_fwd, dim3(grid), dim3(NTHR), LDS_BYTES, stream, a); }
#endif
}
```

```cpp
#include <hip/hip_runtime.h>
#include <cstdio>
#include <cstdint>
#include <cstring>

#ifndef ONE_LAUNCH
#define ONE_LAUNCH 1
#endif

typedef _Float16 f16;
typedef _Float16 f16x8 __attribute__((ext_vector_type(8)));
typedef _Float16 f16x4 __attribute__((ext_vector_type(4)));
typedef _Float16 f16x2 __attribute__((ext_vector_type(2)));
typedef float f32x4 __attribute__((ext_vector_type(4)));
typedef float f32x2 __attribute__((ext_vector_type(2)));
typedef float f32x16 __attribute__((ext_vector_type(16)));
typedef unsigned u32x4 __attribute__((ext_vector_type(4)));

#define GAS __attribute__((address_space(1)))
#define LAS __attribute__((address_space(3)))
typedef GAS unsigned gu32;
#define RLX_AGENT __ATOMIC_RELAXED, __HIP_MEMORY_SCOPE_AGENT
#define LDS_WAIT() asm volatile("s_waitcnt lgkmcnt(0)" ::: "memory")
#define VM_WAIT() asm volatile("s_waitcnt vmcnt(0)" ::: "memory")

namespace pg8 {
#define PG8_LAS __attribute__((address_space(3)))
typedef _Float16 bf16x8 __attribute__((ext_vector_type(8)));
typedef float f32x4 __attribute__((ext_vector_type(4)));
constexpr int BM = 256, BK = 64, HALF = 128, HTB = HALF * BK * 2  , STAGE_BYTES = 8 * HTB, NXCD = 8, WGM = 8;

__host__ __device__ __forceinline__ int lds_byte(int r, int c) { const int st = (r >> 4) * 2 + (c >> 5), rr = r & 15, cc = c & 31, ob = rr * 64 + cc * 2; return st * 1024 + (ob ^ (((ob >> 9) & 1) << 5)); }
__host__ __device__ __forceinline__ void stage_rc(int b, int& R, int& C) { const int st = b / 1024, sb = b % 1024, swz = sb ^ (((sb >> 9) & 1) << 5); R = (st >> 1) * 16 + swz / 64; C = (st & 1) * 32 + (swz % 64) / 2; }
__host__ __device__ __forceinline__ int perm32(int rho) { const int n = rho >> 4, i = rho & 15; return 8 * (i >> 2) + 4 * n + (i & 3); }

struct Unit { int pm, pn, kt0, tag; };
struct Gemm { const void* A; const void* Bt; int ld, nt; };

__device__ __forceinline__ void tile_of(int L, int nM, int nN, int& pm, int& pn) {
    const int nwg = nM * nN; int wgid = L;
    { const int q = nwg / NXCD, r = nwg % NXCD, xcd = wgid % NXCD, off = wgid / NXCD; wgid = (xcd < r ? xcd * (q + 1) : r * (q + 1) + (xcd - r) * q) + off; }
    const int nig = WGM * nN, gid = wgid / nig, fm = gid * WGM, gsz = (nM - fm) < WGM ? (nM - fm) : WGM;
    pm = fm + ((wgid % nig) % gsz); pn = (wgid % nig) / gsz;
}
template <class Epi, class Sched, bool ALIGN_EPI = false, bool SP2 = false>
__device__ __forceinline__ void gemm_phase(PG8_LAS unsigned char* lds, const Gemm g, const Sched& S, const Epi& E) {
    int tid_pin = threadIdx.x; asm volatile("" : "+v"(tid_pin));
    const int tid = tid_pin, wid = __builtin_amdgcn_readfirstlane(tid >> 6), lane = tid & 63, wr = wid >> 2, wc = wid & 3, fr = lane & 15, fq = lane >> 4;
    const int K = g.ld, nt = g.nt;
    unsigned voffA[2], voffB[2];
#pragma unroll
    for (int i = 0; i < 2; ++i) { int R, C; stage_rc(tid * 16 + i * 8192, R, C); const int Rb = Epi::PERM ? ((R & ~31) + perm32(R & 31)) : R;
        voffA[i] = (unsigned)(R * K + C) * 2u; voffB[i] = (unsigned)(Rb * K + C) * 2u; }
    const size_t kstep = (size_t)(BK * 2);
    const size_t hstep = (size_t)HALF * K * 2;
    const size_t tstep = 2 * hstep;
    const unsigned ldsw = (unsigned)wid * 1024u;
    const int aoff = lds_byte(wr * 64 + fr, fq * 8), boff = lds_byte(wc * 32 + fr, fq * 8);
#define PG8_SA(b, h) (((b) * 2 + (h)) * HTB)
#define PG8_SB(b, h) ((4 + (b) * 2 + (h)) * HTB)
#define PG8_STAGE(bufoff, gbase, voff) do { _Pragma("unroll") for (int _i = 0; _i < 2; ++_i) \
        __builtin_amdgcn_global_load_lds((const unsigned*)((const char*)(gbase) + (voff)[_i]), (PG8_LAS unsigned*)(lds + (bufoff) + ldsw + _i * 8192), 16, 0, 0); } while (0)
#define PG8_LDA(dst, b, h) do { _Pragma("unroll") for (int m = 0; m < 4; ++m) _Pragma("unroll") for (int k = 0; k < 2; ++k) dst[m][k] = *(const PG8_LAS bf16x8*)(lds + PG8_SA(b, h) + aoff + m * 2048 + k * 1024); } while (0)
#define PG8_LDB(dst, b, h) do { _Pragma("unroll") for (int n = 0; n < 2; ++n) _Pragma("unroll") for (int k = 0; k < 2; ++k) dst[n][k] = *(const PG8_LAS bf16x8*)(lds + PG8_SB(b, h) + boff + n * 2048 + k * 1024); } while (0)
#define PG8_MMA(ai, bj, At, Bt) do { __builtin_amdgcn_s_setprio(1); _Pragma("unroll") for (int m = 0; m < 4; ++m) _Pragma("unroll") for (int n = 0; n < 2; ++n) _Pragma("unroll") for (int k = 0; k < 2; ++k) \
        acc[ai][bj][m][n] = __builtin_amdgcn_mfma_f32_16x16x32_f16(Bt[n][k], At[m][k], acc[ai][bj][m][n], 0, 0, 0); __builtin_amdgcn_s_setprio(0); } while (0)
#define PG8_WAIT_V(n) asm volatile("s_waitcnt vmcnt(" #n ")" ::: "memory")
#define PG8_WAIT_L(n) asm volatile("s_waitcnt lgkmcnt(" #n ")" ::: "memory")
#define PG8_BAR __builtin_amdgcn_s_barrier()
#define PG8_SCHED __builtin_amdgcn_sched_barrier(0)
    Unit cur, nxt; int ui = 0;
    if (!S.next(0, cur)) return;
    cur.pm = __builtin_amdgcn_readfirstlane(cur.pm); cur.pn = __builtin_amdgcn_readfirstlane(cur.pn); cur.kt0 = __builtin_amdgcn_readfirstlane(cur.kt0); cur.tag = __builtin_amdgcn_readfirstlane(cur.tag);
    f32x4 acc[2][2][4][2];
#pragma unroll
    for (int a = 0; a < 2; ++a)
#pragma unroll
        for (int b = 0; b < 2; ++b)
#pragma unroll
            for (int m = 0; m < 4; ++m)
#pragma unroll
                for (int n = 0; n < 2; ++n) acc[a][b][m][n] = (f32x4){0.f, 0.f, 0.f, 0.f};
    bf16x8 At[4][2], B0[2][2], B1[2][2];
    const char* cA = (const char*)g.A + (size_t)cur.pm * tstep + (size_t)cur.kt0 * (size_t)(BK * 2); const char* cB = (const char*)g.Bt + (size_t)cur.pn * tstep + (size_t)cur.kt0 * (size_t)(BK * 2);
    S.a_ready(cur);
    if constexpr (SP2) {
        PG8_STAGE(PG8_SB(0, 0), cB, voffB); PG8_STAGE(PG8_SB(0, 1), cB + hstep, voffB); PG8_STAGE(PG8_SA(0, 0), cA, voffA); PG8_STAGE(PG8_SA(0, 1), cA + hstep, voffA);
        if (wr == 1) PG8_BAR;
        PG8_WAIT_V(2); PG8_BAR;
        PG8_STAGE(PG8_SB(1, 0), cB + kstep, voffB); PG8_STAGE(PG8_SA(1, 0), cA + kstep, voffA); PG8_STAGE(PG8_SB(1, 1), cB + hstep + kstep, voffB);
        PG8_WAIT_V(6); PG8_BAR;
    } else {
        PG8_STAGE(PG8_SB(0, 0), cB, voffB); PG8_STAGE(PG8_SA(0, 0), cA, voffA); PG8_STAGE(PG8_SB(0, 1), cB + hstep, voffB); PG8_STAGE(PG8_SA(0, 1), cA + hstep, voffA);
        if (wr == 1) PG8_BAR;
        PG8_WAIT_V(4); PG8_BAR;
        PG8_STAGE(PG8_SB(1, 0), cB + kstep, voffB); PG8_STAGE(PG8_SA(1, 0), cA + kstep, voffA); PG8_STAGE(PG8_SB(1, 1), cB + hstep + kstep, voffB);
        PG8_WAIT_V(6); PG8_BAR;
    }
    for (;;) {
        const bool has_next = __builtin_amdgcn_readfirstlane((int)S.next(ui + 1, nxt)) != 0;
        nxt.pm = __builtin_amdgcn_readfirstlane(nxt.pm); nxt.pn = __builtin_amdgcn_readfirstlane(nxt.pn); nxt.kt0 = __builtin_amdgcn_readfirstlane(nxt.kt0); nxt.tag = __builtin_amdgcn_readfirstlane(nxt.tag);
        const char* nA = has_next ? (const char*)g.A + (size_t)nxt.pm * tstep + (size_t)nxt.kt0 * kstep : cA; const char* nB = has_next ? (const char*)g.Bt + (size_t)nxt.pn * tstep + (size_t)nxt.kt0 * kstep : cB;
        for (int t = 0; t < nt; t += 2) {
            const bool last = (t == nt - 2);
            const char* a1 = cA + (size_t)(t + 1) * kstep;
            const char* a2 = last ? nA : cA + (size_t)(t + 2) * kstep; const char* b2 = last ? nB : cB + (size_t)(t + 2) * kstep;
            const char* a3 = a2 + kstep; const char* b3 = b2 + kstep;
            if (last && has_next) S.a_ready(nxt);
            if constexpr (SP2) {
            PG8_LDB(B0, 0, 0); PG8_LDB(B1, 0, 1); PG8_SCHED; PG8_LDA(At, 0, 0); PG8_STAGE(PG8_SA(1, 1), a1 + hstep, voffA);
            PG8_WAIT_V(8); PG8_WAIT_L(0); PG8_BAR; PG8_MMA(0, 0, At, B0); PG8_MMA(0, 1, At, B1); PG8_BAR; PG8_SCHED;
            PG8_LDA(At, 0, 1); PG8_STAGE(PG8_SB(0, 0), b2, voffB); PG8_STAGE(PG8_SB(0, 1), b2 + hstep, voffB); PG8_STAGE(PG8_SA(0, 0), a2, voffA);
            PG8_WAIT_V(8); PG8_WAIT_L(0); PG8_BAR; PG8_MMA(1, 0, At, B0); PG8_MMA(1, 1, At, B1); PG8_BAR; PG8_SCHED;
            PG8_LDB(B0, 1, 0); PG8_LDB(B1, 1, 1); PG8_SCHED; PG8_LDA(At, 1, 0); PG8_STAGE(PG8_SA(0, 1), a2 + hstep, voffA);
            PG8_WAIT_V(8); PG8_WAIT_L(0); PG8_BAR; PG8_MMA(0, 0, At, B0); PG8_MMA(0, 1, At, B1); PG8_BAR; PG8_SCHED;
            PG8_LDA(At, 1, 1); PG8_STAGE(PG8_SB(1, 0), b3, voffB); PG8_STAGE(PG8_SB(1, 1), b3 + hstep, voffB); PG8_STAGE(PG8_SA(1, 0), a3, voffA);
            PG8_WAIT_V(8); PG8_WAIT_L(0); PG8_BAR; PG8_MMA(1, 0, At, B0); PG8_MMA(1, 1, At, B1); PG8_BAR; PG8_SCHED;
            } else {
            PG8_LDB(B0, 0, 0); PG8_SCHED; PG8_LDA(At, 0, 0); PG8_STAGE(PG8_SA(1, 1), a1 + hstep, voffA);
            PG8_WAIT_L(8); PG8_BAR; PG8_WAIT_L(0); PG8_MMA(0, 0, At, B0); PG8_BAR; PG8_SCHED;
            PG8_LDB(B1, 0, 1); PG8_STAGE(PG8_SB(0, 0), b2, voffB);
            PG8_BAR; PG8_WAIT_L(0); PG8_MMA(0, 1, At, B1); PG8_BAR;
            PG8_LDA(At, 0, 1); PG8_STAGE(PG8_SA(0, 0), a2, voffA);
            PG8_BAR; PG8_WAIT_L(0); PG8_MMA(1, 0, At, B0); PG8_BAR; PG8_SCHED;
            PG8_STAGE(PG8_SB(0, 1), b2 + hstep, voffB);
            PG8_WAIT_V(6); PG8_BAR; PG8_MMA(1, 1, At, B1); PG8_BAR;
            PG8_LDB(B0, 1, 0); PG8_SCHED; PG8_LDA(At, 1, 0); PG8_STAGE(PG8_SA(0, 1), a2 + hstep, voffA);
            PG8_WAIT_L(8); PG8_BAR; PG8_WAIT_L(0); PG8_MMA(0, 0, At, B0); PG8_BAR; PG8_SCHED;
            PG8_LDB(B1, 1, 1); PG8_STAGE(PG8_SB(1, 0), b3, voffB);
            PG8_BAR; PG8_WAIT_L(0); PG8_MMA(0, 1, At, B1); PG8_BAR;
            PG8_LDA(At, 1, 1); PG8_STAGE(PG8_SA(1, 0), a3, voffA);
            PG8_BAR; PG8_WAIT_L(0); PG8_MMA(1, 0, At, B0); PG8_BAR; PG8_SCHED;
            PG8_STAGE(PG8_SB(1, 1), b3 + hstep, voffB);
            PG8_WAIT_V(6); PG8_BAR; PG8_MMA(1, 1, At, B1); PG8_BAR;
            }
        }
        if constexpr (ALIGN_EPI) { if (wr == 0) PG8_BAR; }
        if constexpr (!Epi::AFTER_DRAIN) { int fr2 = fr, fq2 = fq, wr2 = wr, wc2 = wc; asm volatile("" : "+v"(fr2), "+v"(fq2), "+s"(wr2), "+s"(wc2)); E(acc, cur, wr2, wc2, fr2, fq2); S.done(cur); }
        if (!has_next) break;
#pragma unroll
        for (int a = 0; a < 2; ++a)
#pragma unroll
            for (int b = 0; b < 2; ++b)
#pragma unroll
                for (int m = 0; m < 4; ++m)
#pragma unroll
                    for (int n = 0; n < 2; ++n) acc[a][b][m][n] = (f32x4){0.f, 0.f, 0.f, 0.f};
        cur = nxt; cA = nA; cB = nB; ++ui;
        if constexpr (ALIGN_EPI) { if (wr == 1) PG8_BAR; }
    }
    PG8_WAIT_V(0);
    if constexpr (!ALIGN_EPI) { if (wr == 0) PG8_BAR; }
    PG8_BAR;
    if constexpr (Epi::AFTER_DRAIN) { E.fused(acc, cur, wr, wc, fr, fq, lds, wid, lane); S.done(cur); }
#undef PG8_SA
#undef PG8_SB
#undef PG8_STAGE
#undef PG8_LDA
#undef PG8_LDB
#undef PG8_MMA
#undef PG8_WAIT_V
#undef PG8_WAIT_L
#undef PG8_BAR
#undef PG8_SCHED
}
}

constexpr int D = 2048, NB = 4, SEQ = 2048, CTXL = 256, TL = NB * SEQ, TC = NB * CTXL, T = TL + TC;
constexpr int NMAIN = 12032;
constexpr int C_NAK = 0, C_GK = 512, C_GV = 768, C_LR = 1280, C_DK = 1312, C_NAQ = 1824, C_GQ = 2336, C_GR = 2592, C_DQ = 3104, C_GATE = 3616;
constexpr int IN_COLS = 13344;
constexpr int KVPOS = 2304;
constexpr int NWAVES = 8, NTHR = 512;
constexpr float LN_EPS = 1e-6f, RMS_EPS = 1e-5f, ALPHA = 1.4142135623730951f;
constexpr int MAXSLOT = 26624;
constexpr int N_PHASES = 2 + 2 * 11;

constexpr size_t MiB = 1u << 20;
constexpr size_t WS_CTL = 0, CTL_ZERO_BYTES = MiB;
constexpr size_t WS_MOD = 1 * MiB, WS_ROUT = 2 * MiB, WS_SLOTW = 3 * MiB, WS_TILES = 3 * MiB + 512 * 1024;
constexpr int WT0 = 4, WT_STRIDE = 55, HT = 114;
constexpr size_t WS_WIN = (size_t)WT0 * MiB, WS_H = (size_t)HT * MiB;
constexpr size_t WS_WBR = 150 * MiB, WS_WOUT = 166 * MiB, WS_WGU = 182 * MiB, WS_WDN = 438 * MiB, WS_TBLL = 566 * MiB, WS_TBLC = 582 * MiB;
constexpr size_t WS_P = 583 * MiB, WS_VTNA = 795 * MiB, WS_VTDF = 804 * MiB, WS_FTL = 813 * MiB, WS_FTC = 829 * MiB, WS_DQ = 831 * MiB, WS_KALL = 839 * MiB;
constexpr size_t WS_YALL = 848 * MiB, WS_GU = 884 * MiB, WS_GS = 920 * MiB, WS_GG = 956 * MiB, WS_FP = 957 * MiB, WS_S16 = 1021 * MiB, WS_S32 = 1057 * MiB;
constexpr size_t WS_XL = 1129 * MiB, WS_ASORT = 1201 * MiB, WS_ACT = 1305 * MiB, WS_SOUT = 1331 * MiB, WS_END = 1435 * MiB;
static_assert(WS_H + (size_t)T * D * 2 <= WS_WBR && WS_P + (size_t)T * NMAIN * 2 <= WS_VTNA && WS_WIN + 2 * (size_t)WT_STRIDE * MiB <= WS_H, "ws map");
constexpr int CW_TMO = 0, CW_CODE = 1, CW_BAR = 4096, CW_CNT = 16384;

constexpr int RING_OFF = 0, SCR_LIMIT = 143360;
constexpr int TBL_OFF = 143360;
constexpr int MISC_OFF = 146944;
constexpr int LDS_BYTES = 147456;

#define XB_TMO      128
#define XB_XCNT(j)  (256  + 64 * (j))
#define XB_XSUB(j)  (1280 + 64 * (j))
#define XB_XGEN(j)  (2304 + 64 * (j))
#define XB_TOP      3328
#define XB_TOPGEN   3392
#define XCD_BAR_WORDS 3456
#define XB_SPIN_CAP (1u << 18)

__device__ __forceinline__ unsigned xb_ld(unsigned* p)              { return __hip_atomic_load(p, __ATOMIC_RELAXED, __HIP_MEMORY_SCOPE_AGENT); }
__device__ __forceinline__ unsigned xb_add(unsigned* p, unsigned v) { return __hip_atomic_fetch_add(p, v, __ATOMIC_RELAXED, __HIP_MEMORY_SCOPE_AGENT); }
__device__ __forceinline__ unsigned xb_xcc_id() { return (unsigned)__builtin_amdgcn_s_getreg((3 << 11) | 20) & 0xFu; }
#define XB_SPIN(cond, bar) do { unsigned _sp = 0; while (cond) { __builtin_amdgcn_s_sleep(1); \
    if ((++_sp & 255u) == 0u) { if (xb_ld(&(bar)[XB_TMO])) break; if (_sp > XB_SPIN_CAP) { atomicAdd(&(bar)[XB_TMO], 1u); break; } } } } while (0)

struct XcdBarrier {
    unsigned* bar; unsigned x;
    volatile LAS unsigned* st;
};

__device__ __forceinline__ XcdBarrier xcd_barrier_post(unsigned* bar, volatile LAS unsigned* st) {
    XcdBarrier b; b.bar = bar; b.x = xb_xcc_id(); b.st = st;
    if (threadIdx.x == 0) (void)xb_add(&bar[XB_XCNT(b.x)], 1u);
    return b;
}
__device__ __forceinline__ void xcd_barrier_complete(unsigned* bar, unsigned x, unsigned& nloc, unsigned& nx) {
    const unsigned G = gridDim.x * gridDim.y * gridDim.z;
    unsigned sum, cnt, mine, sp = 0u;
    for (;;) {
        sum = 0u; cnt = 0u; mine = 0u;
#pragma unroll
        for (unsigned j = 0; j < 16; ++j) { const unsigned c = xb_ld(&bar[XB_XCNT(j)]); sum += c; cnt += (c > 0u) ? 1u : 0u; mine = (j == x) ? c : mine; }
        if (sum == G) break;
        __builtin_amdgcn_s_sleep(1);
        if ((++sp & 255u) == 0u) { if (xb_ld(&bar[XB_TMO])) break; if (sp > XB_SPIN_CAP) { atomicAdd(&bar[XB_TMO], 1u); break; } }
    }
    nloc = mine > 0u ? mine : 1u; nx = cnt > 0u ? cnt : 1u;
}

__device__ __forceinline__ void xcd_barrier(const XcdBarrier& b) {
    asm volatile("s_waitcnt vmcnt(0)" ::: "memory");
    __syncthreads();
    if (threadIdx.x == 0) {
        unsigned* bar = b.bar;
        __builtin_amdgcn_s_waitcnt(0);
        unsigned nloc = b.st[0], nx = b.st[1];
        if (nloc == 0u) { xcd_barrier_complete(bar, b.x, nloc, nx); b.st[0] = nloc; b.st[1] = nx; }
        const unsigned old = xb_add(&bar[XB_XSUB(b.x)], 1u);
        const unsigned gen = old / nloc;
        if (old + 1u == (gen + 1u) * nloc) {
            __builtin_amdgcn_fence(__ATOMIC_RELEASE, "agent");
            asm volatile("s_waitcnt vmcnt(0)" ::: "memory");
            const unsigned og = xb_add(&bar[XB_TOP], 1u);
            const unsigned tg = og / nx;
            if (og + 1u == (tg + 1u) * nx) xb_add(&bar[XB_TOPGEN], 1u);
            else XB_SPIN(xb_ld(&bar[XB_TOPGEN]) == tg, bar);
            __builtin_amdgcn_fence(__ATOMIC_ACQUIRE, "agent");
            xb_add(&bar[XB_XGEN(b.x)], 1u);
            asm volatile("s_waitcnt vmcnt(0)" ::: "memory");
        } else {
            XB_SPIN(xb_ld(&bar[XB_XGEN(b.x)]) == gen, bar);
            __builtin_amdgcn_fence(__ATOMIC_ACQUIRE, "agent");
            asm volatile("s_waitcnt vmcnt(0)" ::: "memory");
        }
    }
    __syncthreads();
}


struct Args { const float* in[25]; float* out; unsigned char* ws; int ph_lo, ph_hi; };
typedef const __attribute__((address_space(4))) Args* KA;

__device__ __forceinline__ float shx(float v, int o, int lane) { return __builtin_bit_cast(float, __builtin_amdgcn_ds_bpermute((lane ^ o) << 2, __builtin_bit_cast(int, v))); }
__device__ __forceinline__ float wave_sum(float v, int lane) {
#pragma unroll
    for (int o = 1; o < 64; o <<= 1) v += shx(v, o, lane);
    return v;
}
__device__ __forceinline__ float siluf(float x) { return x / (1.f + __expf(-x)); }
__device__ __forceinline__ float sigmf(float x) { return 1.f / (1.f + __expf(-x)); }
__device__ __forceinline__ f16x8 pack8(const f32x4 a, const f32x4 b) {
    f16x8 o; o[0] = (f16)a[0]; o[1] = (f16)a[1]; o[2] = (f16)a[2]; o[3] = (f16)a[3]; o[4] = (f16)b[0]; o[5] = (f16)b[1]; o[6] = (f16)b[2]; o[7] = (f16)b[3]; return o;
}
__device__ __forceinline__ f32x4 mfma16(const f16x8 a, const f16x8 b, const f32x4 c) { return __builtin_amdgcn_mfma_f32_16x16x32_f16(a, b, c, 0, 0, 0); }

__device__ __forceinline__ void row_load(const float* p, int lane, f32x4 (&v)[8]) {
#pragma unroll
    for (int j = 0; j < 8; ++j) v[j] = *(const f32x4*)(p + 4 * (lane + 64 * j));
}
__device__ __forceinline__ void row_ln(f32x4 (&v)[8], int lane) {
    float s = 0.f;
#pragma unroll
    for (int j = 0; j < 8; ++j) s += (v[j][0] + v[j][1]) + (v[j][2] + v[j][3]);
    const float mean = wave_sum(s, lane) * (1.f / D);
    float q = 0.f;
#pragma unroll
    for (int j = 0; j < 8; ++j) { v[j] = v[j] - mean; q += (v[j][0] * v[j][0] + v[j][1] * v[j][1]) + (v[j][2] * v[j][2] + v[j][3] * v[j][3]); }
    const float rstd = 1.f / sqrtf(wave_sum(q, lane) * (1.f / D) + LN_EPS);
#pragma unroll
    for (int j = 0; j < 8; ++j) v[j] = v[j] * rstd;
}
__device__ __forceinline__ void row_modulate_store(f32x4 (&v)[8], const float* shift, const float* scale, f16* orow, int lane) {
    row_ln(v, lane);
#pragma unroll
    for (int j = 0; j < 8; ++j) {
        const int c = 4 * (lane + 64 * j);
        const f32x4 sh = *(const f32x4*)(shift + c), sc = *(const f32x4*)(scale + c);
        const f32x4 y = v[j] * (sc + 1.f) + sh;
        f16x4 o; o[0] = (f16)y[0]; o[1] = (f16)y[1]; o[2] = (f16)y[2]; o[3] = (f16)y[3];
        *(f16x4*)(orow + c) = o;
    }
}
__device__ __forceinline__ const float* mod_vec(KA a, int l, int brow, int which) { return (const float*)(a->ws + WS_MOD) + ((size_t)(l * 5 + brow) * 6 + which) * D; }
__device__ __forceinline__ int brow_of(int t) { return t < TL ? (t >> 11) : 4; }

__device__ __forceinline__ void ph_mod_tables(KA a, LAS unsigned char* lds, int tid, int bid, int G) {
    LAS float* cond = (LAS float*)lds;
    LAS float* red = cond + 5 * 2048;
    LAS float* ctab = red + 16 * 5 * 128;
    const float* c = a->in[1]; const float* cctx = a->in[3];
    for (int i = tid; i < 5 * 2048; i += NTHR) { const int r = i >> 11, k = i & 2047; const float v = r < 4 ? c[r * 2048 + k] : cctx[k]; cond[i] = v / (1.f + expf(-v)); }
    for (int i = tid; i < 2048; i += NTHR) ctab[i] = cospif((float)i * (1.f / 1024.f));
    __syncthreads();
    float* MOD = (float*)(a->ws + WS_MOD);
    for (int chunk = bid; chunk < 192; chunk += G) {
        const int l = chunk / 96, col0 = (chunk % 96) * 128, cg = tid & 31, ks = tid >> 5;
        const float* wp = a->in[4] + ((size_t)l * 2048 + ks * 128) * 12288 + col0 + 4 * cg;
        f32x4 acc[5];
#pragma unroll
        for (int r = 0; r < 5; ++r) acc[r] = (f32x4){0.f, 0.f, 0.f, 0.f};
#pragma unroll 4
        for (int k = 0; k < 128; ++k) {
            const f32x4 w = *(const f32x4*)(wp + (size_t)k * 12288);
#pragma unroll
            for (int r = 0; r < 5; ++r) acc[r] += cond[r * 2048 + ks * 128 + k] * w;
        }
#pragma unroll
        for (int r = 0; r < 5; ++r) *(LAS f32x4*)(red + (ks * 5 + r) * 128 + 4 * cg) = acc[r];
        __syncthreads();
        for (int o = tid; o < 640; o += NTHR) {
            const int r = o >> 7, cc = o & 127; float s = 0.f;
#pragma unroll
            for (int k2 = 0; k2 < 16; ++k2) s += red[(k2 * 5 + r) * 128 + cc];
            MOD[(size_t)(l * 5 + r) * 12288 + col0 + cc] = s + a->in[5][l * 12288 + col0 + cc];
        }
        __syncthreads();
    }
    f16* TLp = (f16*)(a->ws + WS_TBLL);
    for (int g = bid * NTHR + tid; g < 2048 * 512; g += G * NTHR) {
        const int k1 = g >> 9, j0 = (g & 511) * 8; f16x8 o;
#pragma unroll
        for (int e = 0; e < 8; ++e) { const int j = j0 + e, n = j & 2047, m = (k1 * n) & 2047; const float v = (j < 2048) ? ctab[m] : -ctab[(m + 1536) & 2047]; o[e] = (f16)(v * 0.022097086912079608f); }
        *(f16x8*)(TLp + (size_t)k1 * 4096 + j0) = o;
    }
    f16* TCp = (f16*)(a->ws + WS_TBLC);
    for (int g = bid * NTHR + tid; g < 256 * 64; g += G * NTHR) {
        const int k1 = g >> 6, j0 = (g & 63) * 8; f16x8 o;
#pragma unroll
        for (int e = 0; e < 8; ++e) { const int j = j0 + e, n = j & 255, m = ((k1 * n) & 255) * 8; const float v = (j < 256) ? ctab[m] : -ctab[(m + 1536) & 2047]; o[e] = (f16)(v * 0.0625f); }
        *(f16x8*)(TCp + (size_t)k1 * 512 + j0) = o;
    }
}

__device__ __forceinline__ void tr_item(const float* W, int N, int K, f16* WT, int drow0, int sc0, int sc1, int k0, LAS float* scr, int lane) {
    const int sc = (lane < 32) ? (sc0 + lane) : (sc1 + lane - 32);
    const float* src = W + (size_t)k0 * N + sc;
#pragma unroll 8
    for (int i = 0; i < 64; ++i) scr[i * 65 + lane] = src[(size_t)i * N];
    LDS_WAIT(); asm volatile("" ::: "memory");
    const int c = lane & 7;
#pragma unroll
    for (int j = 0; j < 8; ++j) {
        const int n = (lane >> 3) + 8 * j; const LAS float* s = scr + (8 * c) * 65 + n; f16x8 o;
#pragma unroll
        for (int e = 0; e < 8; ++e) o[e] = (f16)s[e * 65];
        *(f16x8*)(WT + (size_t)(drow0 + n) * K + k0 + 8 * c) = o;
    }
    LDS_WAIT(); asm volatile("" ::: "memory");
}
__device__ __forceinline__ int win_src_col(int drow) {
    if (drow < 512) return drow;
    if (drow < 768) return 1024 + (drow - 512);
    if (drow < 1280) return 1280 + (drow - 768);
    if (drow < 1312) return 1792 + (drow - 1280);
    if (drow < 1824) return 1824 + (drow - 1312);
    if (drow < 2336) return 2848 + (drow - 1824);
    if (drow < 2592) return 3360 + (drow - 2336);
    if (drow < 3104) return 3616 + (drow - 2592);
    if (drow < 3616) return 4640 + (drow - 3104);
    if (drow < 11808) return 5152 + (drow - 3616);
    return 5152;
}
__device__ __forceinline__ void ph_convert(KA a, LAS unsigned char* lds, int tid, int bid, int G) {
    const int lane = tid & 63, wave = tid >> 6;
    LAS float* scr = (LAS float*)(lds + wave * 16640);
    const int gw = bid * NWAVES + wave, NGW = G * NWAVES;
    constexpr int I_MAIN = 185 * 32, I_VT = 16 * 32, I_BR = 4 * 32 * 8, I_OUT = 32 * 32, I_GU = 32 * 16 * 32, I_DN = 32 * 32 * 8;
    constexpr int I_L = I_MAIN + I_VT + I_BR + I_OUT + I_GU + I_DN;
    for (int it = gw; it < 2 * I_L; it += NGW) {
        const int l = it / I_L; int r = it % I_L;
        f16* WinT = (f16*)(a->ws + WS_WIN) + (size_t)l * WT_STRIDE * 256 * 2048;
        if (r < I_MAIN) { const int db = r >> 5, kb = r & 31; const int d0 = db * 64;
            tr_item(a->in[6] + (size_t)l * D * IN_COLS, IN_COLS, D, WinT, d0, win_src_col(d0), win_src_col(d0 + 32), kb * 64, scr, lane); continue; }
        r -= I_MAIN;
        if (r < I_VT) { const int db = r >> 5, kb = r & 31; const int sc = db < 8 ? 512 + 64 * db : 2336 + 64 * (db - 8);
            tr_item(a->in[6] + (size_t)l * D * IN_COLS, IN_COLS, D, WinT, NMAIN + db * 64, sc, sc + 32, kb * 64, scr, lane); continue; }
        r -= I_VT;
        if (r < I_BR) { const int g = r >> 8, rr = r & 255, nb = rr >> 3, kb = rr & 7;
            tr_item(a->in[13] + (size_t)(l * 4 + g) * 512 * D, D, 512, (f16*)(a->ws + WS_WBR) + (size_t)(l * 4 + g) * D * 512, nb * 64, nb * 64, nb * 64 + 32, kb * 64, scr, lane); continue; }
        r -= I_BR;
        if (r < I_OUT) { const int nb = r >> 5, kb = r & 31;
            tr_item(a->in[14] + (size_t)l * D * D, D, D, (f16*)(a->ws + WS_WOUT) + (size_t)l * D * D, nb * 64, nb * 64, nb * 64 + 32, kb * 64, scr, lane); continue; }
        r -= I_OUT;
        if (r < I_GU) { const int e = r >> 9, rr = r & 511, db = rr >> 5, kb = rr & 31;
            const int d32a = 2 * db, d32b = 2 * db + 1;
            const int sa = ((d32a & 7) >> 2) * 512 + 128 * (d32a >> 3) + 32 * (d32a & 3), sb = ((d32b & 7) >> 2) * 512 + 128 * (d32b >> 3) + 32 * (d32b & 3);
            tr_item(a->in[23] + (size_t)(l * 32 + e) * D * 1024, 1024, D, (f16*)(a->ws + WS_WGU) + (size_t)(l * 32 + e) * 1024 * D, db * 64, sa, sb, kb * 64, scr, lane); continue; }
        r -= I_GU;
        { const int e = r >> 8, rr = r & 255, nb = rr >> 3, kb = rr & 7;
            tr_item(a->in[24] + (size_t)(l * 32 + e) * 512 * D, D, 512, (f16*)(a->ws + WS_WDN) + (size_t)(l * 32 + e) * D * 512, nb * 64, nb * 64, nb * 64 + 32, kb * 64, scr, lane); }
    }
    __syncthreads();
    {
        LAS float* Wt = (LAS float*)lds;
        LAS float* tab = Wt + 64 * 129;
        for (int u = bid; u < 256; u += G) {
            const int l = u >> 7, g = (u >> 5) & 3, kc = u & 31, k0 = kc * 64;
            const float* src = a->in[6] + ((size_t)l * D + k0) * IN_COLS + 4128 + g * 128;
            for (int i = tid; i < 64 * 128; i += NTHR) { const int kk = i >> 7, c = i & 127; Wt[kk * 129 + c] = src[(size_t)kk * IN_COLS + c]; }
            if (tid < 128) tab[tid] = cospif((float)tid * (1.f / 64.f));
            __syncthreads();
            const int kk = tid & 63, rb = tid >> 6;
            float acc[32];
#pragma unroll
            for (int j = 0; j < 32; ++j) acc[j] = 0.f;
            for (int c = 0; c < 128; ++c) {
                const float w = Wt[kk * 129 + c];
#pragma unroll
                for (int j = 0; j < 32; ++j) { const int rr = rb + 8 * j, k2 = rr & 127, trig = rr >> 7; const int m = (k2 * c + (trig ? 96 : 0)) & 127; acc[j] += w * tab[m]; }
            }
            f16* WinT = (f16*)(a->ws + WS_WIN) + (size_t)l * WT_STRIDE * 256 * 2048;
#pragma unroll
            for (int j = 0; j < 32; ++j) { const int rr = rb + 8 * j, k2 = rr & 127, trig = rr >> 7;
                WinT[(size_t)(NMAIN + 1024 + trig * 512 + g * 128 + k2) * D + k0 + kk] = (f16)(acc[j] * 0.08838834764831845f); }
            __syncthreads();
        }
    }
    {
        f16* H = (f16*)(a->ws + WS_H);
        for (int t = gw; t < T; t += NGW) {
            const float* src = t < TL ? a->in[0] + (size_t)t * D : a->in[2] + (size_t)(t - TL) * D;
            f32x4 v[8]; row_load(src, lane, v);
            const int br = brow_of(t);
            row_modulate_store(v, mod_vec(a, 0, br, 0), mod_vec(a, 0, br, 1), H + (size_t)t * D, lane);
        }
    }
}

struct InProjSched {
    int G, c, l;
    __device__ __forceinline__ bool next(int i, pg8::Unit& u) const {
        int L = i * G + c, pm, pn; u.kt0 = 0; const int wt = WT0 + WT_STRIDE * l;
        if (l == 0) {
            if (L < 36 * 47) { pg8::tile_of(L, 36, 47, pm, pn); u.pm = HT + pm; u.pn = wt + pn; u.tag = 0; return true; } L -= 36 * 47;
            if (L < 8 * 36) { pg8::tile_of(L, 8, 36, pm, pn); u.pm = wt + 47 + pm; u.pn = HT + pn; u.tag = 1; return true; }
            return false;
        }
        if (L < 32 * 47) { pg8::tile_of(L, 32, 47, pm, pn); u.pm = HT + pm; u.pn = wt + pn; u.tag = 0; return true; } L -= 32 * 47;
        if (L < 4 * 8) { pg8::tile_of(L, 4, 8, pm, pn); u.pm = HT + 32 + pm; u.pn = wt + pn; u.tag = 0; return true; } L -= 4 * 8;
        if (L < 8 * 32) { pg8::tile_of(L, 8, 32, pm, pn); u.pm = wt + 47 + pm; u.pn = HT + pn; u.tag = 1; return true; } L -= 8 * 32;
        if (L < 4 * 4) { pg8::tile_of(L, 4, 4, pm, pn); u.pm = wt + 47 + pm; u.pn = HT + 32 + pn; u.tag = 1; return true; }
        return false;
    }
    __device__ __forceinline__ void a_ready(const pg8::Unit&) const {}
    __device__ __forceinline__ void done(const pg8::Unit&) const {}
};
struct Merge2Sched {
    int G, c, nM;
    __device__ __forceinline__ bool next(int i, pg8::Unit& u) const { const int L = i * G + c; if (L >= nM * 8) return false; int pm, pn; pg8::tile_of(L, nM, 8, pm, pn); u.pm = pm; u.pn = pn; u.kt0 = 0; u.tag = 0; return true; }
    __device__ __forceinline__ void a_ready(const pg8::Unit&) const {}
    __device__ __forceinline__ void done(const pg8::Unit&) const {}
};

struct EpiInProj {
    static constexpr bool PERM = true, AFTER_DRAIN = false;
    unsigned char* ws; int wt;
    __device__ __forceinline__ void operator()(const f32x4 (&acc)[2][2][4][2], const pg8::Unit& u, int wr, int wc, int fr, int fq) const {
        if (u.tag == 0) {
            f16* P = (f16*)(ws + WS_P);
            const int row0 = (u.pm - HT) * 256 + wr * 64 + fr, col0 = (u.pn - wt) * 256 + wc * 32 + 8 * fq;
#pragma unroll
            for (int ai = 0; ai < 2; ++ai)
#pragma unroll
                for (int m = 0; m < 4; ++m) { f16* rowp = P + (size_t)(row0 + ai * 128 + m * 16) * NMAIN + col0;
#pragma unroll
                    for (int bj = 0; bj < 2; ++bj) *(f16x8*)(rowp + bj * 128) = pack8(acc[ai][bj][m][0], acc[ai][bj][m][1]); }
        } else {
            const int feat0 = (u.pm - wt - 47) * 256 + wr * 64 + fr, tok0 = (u.pn - HT) * 256 + wc * 32 + 8 * fq;
#pragma unroll
            for (int ai = 0; ai < 2; ++ai)
#pragma unroll
                for (int m = 0; m < 4; ++m) { const int feat = feat0 + ai * 128 + m * 16, seg = feat >> 9, f = feat & 511;
#pragma unroll
                    for (int bj = 0; bj < 2; ++bj) { const int tok = tok0 + bj * 128; f16* dst;
                        if (tok < TL) { const int b = tok >> 11, n = tok & 2047;
                            if (seg < 2) dst = (f16*)(ws + (seg == 0 ? WS_VTNA : WS_VTDF)) + (size_t)(b * 512 + f) * KVPOS + 256 + n;
                            else dst = (f16*)(ws + WS_FTL) + (size_t)(b * 512 + f) * 4096 + (seg - 2) * 2048 + n;
                        } else { const int t = tok - TL, b = t >> 8, tt = t & 255;
                            if (seg < 2) dst = (f16*)(ws + (seg == 0 ? WS_VTNA : WS_VTDF)) + (size_t)(b * 512 + f) * KVPOS + tt;
                            else dst = (f16*)(ws + WS_FTC) + (size_t)(b * 512 + f) * 512 + (seg - 2) * 256 + tt;
                        }
                        *(f16x8*)dst = pack8(acc[ai][bj][m][0], acc[ai][bj][m][1]); } }
        }
    }
};

__device__ __forceinline__ int gla_uid(int s, int h, int dir, int c) { return s < 4 ? ((s * 4 + h) * 2 + dir) * 32 + c : 1024 + (((s - 4) * 4 + h) * 2 + dir) * 4 + c; }
constexpr int GL_Q = 0, GL_K = 4160, GL_CUM = 8320, GL_SST = 4160, GL_V = 12480, GL_AM = 20736, GL_OS = 24896, GL_LR = 33152, GL_PART = 34176;
__device__ __forceinline__ int gla_tok(int s, int dir, int c, int i) { const int L = s < 4 ? 2048 : 256; const int pos = dir ? (L - 1 - (64 * c + i)) : (64 * c + i); return s < 4 ? s * 2048 + pos : TL + (s - 4) * 256 + pos; }
__device__ __forceinline__ void gla_load_chunk(KA a, LAS float* F, int l, int s, int h, int dir, int c, bool with_q, int tid) {
    const f16* P = (const f16*)(a->ws + WS_P);
    { const int i = tid >> 3, cc = (tid & 7) * 8; const f16* row = P + (size_t)gla_tok(s, dir, c, i) * NMAIN;
      const f16x8 kv = *(const f16x8*)(row + C_GK + h * 64 + cc);
#pragma unroll
      for (int e = 0; e < 8; ++e) F[GL_K + i * 65 + cc + e] = (float)kv[e];
      if (with_q) { const f16x8 qv = *(const f16x8*)(row + C_GQ + h * 64 + cc);
#pragma unroll
          for (int e = 0; e < 8; ++e) F[GL_Q + i * 65 + cc + e] = (float)qv[e]; } }
#pragma unroll
    for (int p = 0; p < 2; ++p) { const int idx = tid + p * NTHR, i = idx >> 4, cc = (idx & 15) * 8;
      const f16x8 vv = *(const f16x8*)(P + (size_t)gla_tok(s, dir, c, i) * NMAIN + C_GV + h * 128 + cc);
#pragma unroll
      for (int e = 0; e < 8; ++e) F[GL_V + i * 129 + cc + e] = (float)vv[e]; }
    if (tid < 128) { const int i = tid >> 1, cc = (tid & 1) * 8;
      const f16x8 lv = *(const f16x8*)(P + (size_t)gla_tok(s, dir, c, i) * NMAIN + C_LR + dir * 16 + cc);
#pragma unroll
      for (int e = 0; e < 8; ++e) F[GL_LR + i * 16 + cc + e] = (float)lv[e]; }
    __syncthreads();
    { const int d = tid & 63, grp = tid >> 6;
      const float* wg = a->in[8] + (size_t)((l * 2 + dir) * 16) * 256 + h * 64 + d;
      float w[16];
#pragma unroll
      for (int r = 0; r < 16; ++r) w[r] = wg[r * 256];
      const float bias = a->in[9][(l * 2 + dir) * 256 + h * 64 + d];
      float run = 0.f;
#pragma unroll
      for (int r8 = 0; r8 < 8; ++r8) { const int i = grp * 8 + r8; float z = bias;
#pragma unroll
          for (int r = 0; r < 16; ++r) z += F[GL_LR + i * 16 + r] * w[r];
          const float la = (fminf(z, 0.f) - log1pf(expf(-fabsf(z)))) * (1.f / 16.f);
          run += la; F[GL_CUM + i * 65 + d] = run; }
      F[GL_PART + grp * 64 + d] = run;
      __syncthreads();
      float off = 0.f;
      for (int g2 = 0; g2 < grp; ++g2) off += F[GL_PART + g2 * 64 + d];
#pragma unroll
      for (int r8 = 0; r8 < 8; ++r8) F[GL_CUM + (grp * 8 + r8) * 65 + d] += off;
    }
    __syncthreads();
}
__device__ __forceinline__ void gla_g1_unit(KA a, LAS float* F, int l, int s, int h, int dir, int c, int tid) {
    gla_load_chunk(a, F, l, s, h, dir, c, false, tid);
    const int uid = gla_uid(s, h, dir, c);
    for (int idx = tid; idx < 4096; idx += NTHR) { const int i = idx >> 6, d = idx & 63; F[GL_K + i * 65 + d] *= expf(F[GL_CUM + 63 * 65 + d] - F[GL_CUM + i * 65 + d]); }
    if (tid < 64) ((float*)(a->ws + WS_GG))[(size_t)uid * 64 + tid] = expf(F[GL_CUM + 63 * 65 + tid]);
    __syncthreads();
    const int lane = tid & 63, w = tid >> 6, mi = w >> 2, nj = w & 3, r = lane & 31, hk = lane >> 5;
    f32x16 acc;
#pragma unroll
    for (int e = 0; e < 16; ++e) acc[e] = 0.f;
#pragma unroll 8
    for (int t0 = 0; t0 < 64; t0 += 2) { const float av = F[GL_K + (t0 + hk) * 65 + 32 * mi + r], bv = F[GL_V + (t0 + hk) * 129 + 32 * nj + r]; acc = __builtin_amdgcn_mfma_f32_32x32x2f32(av, bv, acc, 0, 0, 0); }
    float* U = (float*)(a->ws + WS_GU) + (size_t)uid * 8192;
#pragma unroll
    for (int e = 0; e < 16; ++e) { const int row = 32 * mi + (e & 3) + 8 * (e >> 2) + 4 * hk; U[row * 128 + 32 * nj + r] = acc[e]; }
    __syncthreads();
}
__device__ __forceinline__ void gla_scan(KA a, int tid, int bid, int G) {
    const float* __restrict__ U = (const float*)(a->ws + WS_GU); const float* __restrict__ GGp = (const float*)(a->ws + WS_GG); float* __restrict__ S = (float*)(a->ws + WS_GS);
    for (int u = bid; u < 512; u += G) {
        const int seq = u >> 4, part = u & 15;
        const int idx = part * NTHR + tid, dk = idx >> 7;
        const int uC = 1024 + seq * 4, uL = seq * 32;
        float s = 0.f;
#pragma unroll
        for (int c = 0; c < 4; ++c) { const float uu = U[(size_t)(uC + c) * 8192 + idx], gd = GGp[(uC + c) * 64 + dk]; S[(size_t)(uC + c) * 8192 + idx] = s; s = gd * s + uu; }
#pragma unroll 8
        for (int c = 0; c < 32; ++c) { const float uu = U[(size_t)(uL + c) * 8192 + idx], gd = GGp[(uL + c) * 64 + dk]; S[(size_t)(uL + c) * 8192 + idx] = s; s = gd * s + uu; }
    }
}
__device__ __forceinline__ void gla_g3_unit(KA a, LAS float* F, int l, int s, int h, int c, int tid) {
    const int lane = tid & 63, w = tid >> 6, r = lane & 31, hk = lane >> 5;
    const int nc = s < 4 ? 32 : 4;
    for (int dir = 0; dir < 2; ++dir) {
        const int cd = dir ? nc - 1 - c : c;
        gla_load_chunk(a, F, l, s, h, dir, cd, true, tid);
        for (int idx = tid; idx < 4096; idx += NTHR) { const int i = idx >> 6, d = idx & 63; const float cu = F[GL_CUM + i * 65 + d];
            F[GL_Q + i * 65 + d] *= expf(cu) * 0.125f; F[GL_K + i * 65 + d] *= expf(-cu); }
        __syncthreads();
        if (w < 4) { const int mi = w >> 1, nj = w & 1; f32x16 acc;
#pragma unroll
            for (int e = 0; e < 16; ++e) acc[e] = 0.f;
#pragma unroll 8
            for (int d0 = 0; d0 < 64; d0 += 2) { const float av = F[GL_Q + (32 * mi + r) * 65 + d0 + hk], bv = F[GL_K + (32 * nj + r) * 65 + d0 + hk]; acc = __builtin_amdgcn_mfma_f32_32x32x2f32(av, bv, acc, 0, 0, 0); }
#pragma unroll
            for (int e = 0; e < 16; ++e) { const int i = 32 * mi + (e & 3) + 8 * (e >> 2) + 4 * hk, j = 32 * nj + r; F[GL_AM + i * 65 + j] = (i >= j) ? acc[e] : 0.f; } }
        __syncthreads();
        { const float* Sg = (const float*)(a->ws + WS_GS) + (size_t)gla_uid(s, h, dir, cd) * 8192;
#pragma unroll
          for (int p = 0; p < 4; ++p) { const int idx = (tid + p * NTHR) * 4, dk = idx >> 7, dv = idx & 127; const f32x4 v = *(const f32x4*)(Sg + idx);
              F[GL_SST + dk * 129 + dv] = v[0]; F[GL_SST + dk * 129 + dv + 1] = v[1]; F[GL_SST + dk * 129 + dv + 2] = v[2]; F[GL_SST + dk * 129 + dv + 3] = v[3]; } }
        __syncthreads();
        { const int mi = w >> 2, nj = w & 3; f32x16 acc;
#pragma unroll
          for (int e = 0; e < 16; ++e) acc[e] = 0.f;
#pragma unroll 8
          for (int j0 = 0; j0 < 64; j0 += 2) { const float av = F[GL_AM + (32 * mi + r) * 65 + j0 + hk], bv = F[GL_V + (j0 + hk) * 129 + 32 * nj + r]; acc = __builtin_amdgcn_mfma_f32_32x32x2f32(av, bv, acc, 0, 0, 0); }
#pragma unroll 8
          for (int d0 = 0; d0 < 64; d0 += 2) { const float av = F[GL_Q + (32 * mi + r) * 65 + d0 + hk], bv = F[GL_SST + (d0 + hk) * 129 + 32 * nj + r]; acc = __builtin_amdgcn_mfma_f32_32x32x2f32(av, bv, acc, 0, 0, 0); }
#pragma unroll
          for (int e = 0; e < 16; ++e) { const int i = 32 * mi + (e & 3) + 8 * (e >> 2) + 4 * hk, p = dir ? 63 - i : i, col = 32 * nj + r;
              if (dir == 0) F[GL_OS + p * 129 + col] = acc[e]; else F[GL_OS + p * 129 + col] += acc[e]; } }
        __syncthreads();
    }
    { const f16* P = (const f16*)(a->ws + WS_P); f16* Y = (f16*)(a->ws + WS_YALL) + (size_t)1 * T * 512;
      const float g0 = a->in[10][l * 128 + lane], g1 = a->in[10][l * 128 + lane + 64];
#pragma unroll
      for (int rr = 0; rr < 8; ++rr) { const int p = w * 8 + rr; const int tok = gla_tok(s, 0, c, p);
          const float o0 = F[GL_OS + p * 129 + lane], o1 = F[GL_OS + p * 129 + lane + 64];
          const float ss = wave_sum(o0 * o0 + o1 * o1, lane), rinv = 1.f / sqrtf(ss * (1.f / 128.f) + RMS_EPS);
          const float r0 = (float)P[(size_t)tok * NMAIN + C_GR + h * 128 + lane], r1 = (float)P[(size_t)tok * NMAIN + C_GR + h * 128 + lane + 64];
          Y[(size_t)tok * 512 + h * 128 + lane] = (f16)(o0 * rinv * g0 * siluf(r0)); Y[(size_t)tok * 512 + h * 128 + lane + 64] = (f16)(o1 * rinv * g1 * siluf(r1)); } }
    __syncthreads();
}

__device__ __forceinline__ void na_unit(KA a, int l, int b, int h, bool lat, int r, int j, int qt, int lane) {
    const f16* P = (const f16*)(a->ws + WS_P);
    const f16* VT = (const f16*)(a->ws + WS_VTNA) + (size_t)(b * 512 + h * 128) * KVPOS;
    const int ql = lane & 15, g = lane >> 4;
    const int qtok = lat ? b * 2048 + r * 64 + j * 16 + ql : TL + b * 256 + qt * 16 + ql;
    f16x8 bq[4];
#pragma unroll
    for (int kk = 0; kk < 4; ++kk) bq[kk] = *(const f16x8*)(P + (size_t)qtok * NMAIN + C_NAQ + h * 128 + 32 * kk + 8 * g);
    f32x4 o[8];
#pragma unroll
    for (int dt = 0; dt < 8; ++dt) o[dt] = (f32x4){0.f, 0.f, 0.f, 0.f};
    float m = -1e30f, lsum = 0.f;
    const float scale = 0.08838834764831845f;
    const int row0 = min(max(r - 4, 0), 24), band0 = min(max(16 * j - 8, 0), 32), qcol = 16 * j + ql, wst = min(max(qcol - 8, 0), 48);
    const float* rpb = a->in[7] + (size_t)(l * 4 + h) * 15 * 31;
    const int nsteps = lat ? 16 : 8;
    for (int st = 0; st < nsteps; ++st) {
        const bool islat = lat && st < 8;
        int ktok0, pos0;
        if (islat) { const int kr = row0 + st; ktok0 = b * 2048 + kr * 64 + band0; pos0 = 256 + kr * 64 + band0; }
        else { const int cs = lat ? st - 8 : st; ktok0 = TL + b * 256 + cs * 32; pos0 = cs * 32; }
        const f16* kp0 = P + (size_t)(ktok0 + ql) * NMAIN + C_NAK + h * 128 + 8 * g; const f16* kp1 = kp0 + (size_t)16 * NMAIN;
        f32x4 s0 = (f32x4){0.f, 0.f, 0.f, 0.f}, s1 = (f32x4){0.f, 0.f, 0.f, 0.f};
#pragma unroll
        for (int kk = 0; kk < 4; ++kk) { const f16x8 k0 = *(const f16x8*)(kp0 + 32 * kk), k1 = *(const f16x8*)(kp1 + 32 * kk); s0 = mfma16(k0, bq[kk], s0); s1 = mfma16(k1, bq[kk], s1); }
        float sv[8];
#pragma unroll
        for (int i = 0; i < 4; ++i) { sv[i] = s0[i] * scale; sv[4 + i] = s1[i] * scale; }
        if (islat) { const int dr = row0 + st - r;
#pragma unroll
            for (int i = 0; i < 8; ++i) { const int kc = band0 + 4 * g + (i & 3) + 16 * (i >> 2), dc = kc - qcol; const bool ok = kc >= wst && kc < wst + 16;
                const float bias = rpb[(dr + 7) * 31 + min(max(dc + 15, 0), 30)]; sv[i] = ok ? sv[i] + bias : -1e30f; } }
        float mx = sv[0];
#pragma unroll
        for (int i = 1; i < 8; ++i) mx = fmaxf(mx, sv[i]);
        mx = fmaxf(mx, shx(mx, 16, lane)); mx = fmaxf(mx, shx(mx, 32, lane));
        const float mnew = fmaxf(m, mx), alpha = __expf(m - mnew); m = mnew;
        float ps = 0.f; float p[8];
#pragma unroll
        for (int i = 0; i < 8; ++i) { p[i] = __expf(sv[i] - mnew); ps += p[i]; }
        lsum = lsum * alpha + ps;
        f16x8 pb;
#pragma unroll
        for (int i = 0; i < 8; ++i) pb[i] = (f16)p[i];
#pragma unroll
        for (int dt = 0; dt < 8; ++dt) { const f16* vp = VT + (size_t)(16 * dt + ql) * KVPOS + pos0 + 4 * g;
            const f16x4 va = *(const f16x4*)vp, vb = *(const f16x4*)(vp + 16); f16x8 av;
            av[0] = va[0]; av[1] = va[1]; av[2] = va[2]; av[3] = va[3]; av[4] = vb[0]; av[5] = vb[1]; av[6] = vb[2]; av[7] = vb[3];
            o[dt] = mfma16(av, pb, o[dt] * alpha); }
    }
    lsum += shx(lsum, 16, lane); lsum += shx(lsum, 32, lane);
    const float inv = 1.f / lsum;
    f16* Y = (f16*)(a->ws + WS_YALL) + (size_t)qtok * 512 + h * 128 + 4 * g;
#pragma unroll
    for (int dt = 0; dt < 8; ++dt) { f16x4 ov; ov[0] = (f16)(o[dt][0] * inv); ov[1] = (f16)(o[dt][1] * inv); ov[2] = (f16)(o[dt][2] * inv); ov[3] = (f16)(o[dt][3] * inv); *(f16x4*)(Y + 16 * dt) = ov; }
}

__device__ __forceinline__ void diff_unit(KA a, int l, int b, int h, bool lat, int qt, float lam, float lam_init, int lane) {
    const int ql = lane & 15, g = lane >> 4;
    const int qtok = lat ? b * 2048 + qt * 16 + ql : TL + b * 256 + qt * 16 + ql;
    const f16* qrow = lat ? (const f16*)(a->ws + WS_DQ) + (size_t)qtok * 512 + h * 128 : (const f16*)(a->ws + WS_P) + (size_t)qtok * NMAIN + C_DQ + h * 128;
    f16x8 bq[2][2];
#pragma unroll
    for (int mm = 0; mm < 2; ++mm)
#pragma unroll
        for (int kk = 0; kk < 2; ++kk) bq[mm][kk] = *(const f16x8*)(qrow + mm * 64 + 32 * kk + 8 * g);
    const f16* KA = (const f16*)(a->ws + WS_KALL) + (size_t)b * KVPOS * 512 + h * 128 + 8 * g;
    const f16* VT = (const f16*)(a->ws + WS_VTDF) + (size_t)(b * 512 + h * 128) * KVPOS;
    f32x4 o1[8], o2[8];
#pragma unroll
    for (int dt = 0; dt < 8; ++dt) { o1[dt] = (f32x4){0.f, 0.f, 0.f, 0.f}; o2[dt] = (f32x4){0.f, 0.f, 0.f, 0.f}; }
    float m1 = -1e30f, m2 = -1e30f, l1 = 0.f, l2 = 0.f;
    const int nsteps = lat ? 72 : 8;
    for (int st = 0; st < nsteps; ++st) {
        const int pos0 = st * 32;
        const f16* kp0 = KA + (size_t)(pos0 + ql) * 512; const f16* kp1 = kp0 + 16 * 512;
        f32x4 sa0 = (f32x4){0.f, 0.f, 0.f, 0.f}, sa1 = sa0, sb0 = sa0, sb1 = sa0;
#pragma unroll
        for (int kk = 0; kk < 2; ++kk) {
            const f16x8 ka0 = *(const f16x8*)(kp0 + 32 * kk), ka1 = *(const f16x8*)(kp1 + 32 * kk), kb0 = *(const f16x8*)(kp0 + 64 + 32 * kk), kb1 = *(const f16x8*)(kp1 + 64 + 32 * kk);
            sa0 = mfma16(ka0, bq[0][kk], sa0); sa1 = mfma16(ka1, bq[0][kk], sa1); sb0 = mfma16(kb0, bq[1][kk], sb0); sb1 = mfma16(kb1, bq[1][kk], sb1); }
        float pa[8], pb2[8]; float mxa, mxb;
#pragma unroll
        for (int i = 0; i < 4; ++i) { pa[i] = sa0[i] * 0.125f; pa[4 + i] = sa1[i] * 0.125f; pb2[i] = sb0[i] * 0.125f; pb2[4 + i] = sb1[i] * 0.125f; }
        mxa = pa[0]; mxb = pb2[0];
#pragma unroll
        for (int i = 1; i < 8; ++i) { mxa = fmaxf(mxa, pa[i]); mxb = fmaxf(mxb, pb2[i]); }
        mxa = fmaxf(mxa, shx(mxa, 16, lane)); mxa = fmaxf(mxa, shx(mxa, 32, lane)); mxb = fmaxf(mxb, shx(mxb, 16, lane)); mxb = fmaxf(mxb, shx(mxb, 32, lane));
        const float n1 = fmaxf(m1, mxa), n2 = fmaxf(m2, mxb), al1 = __expf(m1 - n1), al2 = __expf(m2 - n2); m1 = n1; m2 = n2;
        float s1 = 0.f, s2 = 0.f; f16x8 p1, p2;
#pragma unroll
        for (int i = 0; i < 8; ++i) { const float e1 = __expf(pa[i] - n1), e2 = __expf(pb2[i] - n2); s1 += e1; s2 += e2; p1[i] = (f16)e1; p2[i] = (f16)e2; }
        l1 = l1 * al1 + s1; l2 = l2 * al2 + s2;
#pragma unroll
        for (int dt = 0; dt < 8; ++dt) { const f16* vp = VT + (size_t)(16 * dt + ql) * KVPOS + pos0 + 4 * g;
            const f16x4 va = *(const f16x4*)vp, vb = *(const f16x4*)(vp + 16); f16x8 av;
            av[0] = va[0]; av[1] = va[1]; av[2] = va[2]; av[3] = va[3]; av[4] = vb[0]; av[5] = vb[1]; av[6] = vb[2]; av[7] = vb[3];
            o1[dt] = mfma16(av, p1, o1[dt] * al1); o2[dt] = mfma16(av, p2, o2[dt] * al2); }
    }
    l1 += shx(l1, 16, lane); l1 += shx(l1, 32, lane); l2 += shx(l2, 16, lane); l2 += shx(l2, 32, lane);
    const float i1 = 1.f / l1, i2 = lam / l2;
    float ss = 0.f;
#pragma unroll
    for (int dt = 0; dt < 8; ++dt) { o1[dt] = o1[dt] * i1 - o2[dt] * i2; ss += (o1[dt][0] * o1[dt][0] + o1[dt][1] * o1[dt][1]) + (o1[dt][2] * o1[dt][2] + o1[dt][3] * o1[dt][3]); }
    ss += shx(ss, 16, lane); ss += shx(ss, 32, lane);
    const float rinv = (1.f - lam_init) / sqrtf(ss * (1.f / 128.f) + RMS_EPS);
    const float* gain = a->in[12] + l * 128 + 4 * g;
    f16* Y = (f16*)(a->ws + WS_YALL) + (size_t)3 * T * 512 + (size_t)qtok * 512 + h * 128 + 4 * g;
#pragma unroll
    for (int dt = 0; dt < 8; ++dt) { const f32x4 gv = *(const f32x4*)(gain + 16 * dt); f16x4 ov;
        ov[0] = (f16)(o1[dt][0] * rinv * gv[0]); ov[1] = (f16)(o1[dt][1] * rinv * gv[1]); ov[2] = (f16)(o1[dt][2] * rinv * gv[2]); ov[3] = (f16)(o1[dt][3] * rinv * gv[3]); *(f16x4*)(Y + 16 * dt) = ov; }
}
__device__ __forceinline__ void rope_row(KA a, int t, int lane) {
    const f16* P = (const f16*)(a->ws + WS_P) + (size_t)t * NMAIN;
    f16* KALL = (f16*)(a->ws + WS_KALL);
    if (t >= TL) { const int tt = t - TL, b = tt >> 8, p = tt & 255; *(f16x8*)(KALL + ((size_t)b * KVPOS + p) * 512 + 8 * lane) = *(const f16x8*)(P + C_DK + 8 * lane); return; }
    const int b = t >> 11, n = t & 2047, grow = n >> 6, gcol = n & 63;
    const int blk = lane >> 3, i0 = 2 * (lane & 7);
    f16* dq = (f16*)(a->ws + WS_DQ) + (size_t)t * 512; f16* dk = KALL + ((size_t)b * KVPOS + 256 + n) * 512;
#pragma unroll
    for (int half = 0; half < 2; ++half) {
        const float pos = (float)(half ? gcol : grow);
        float cs[2], sn[2];
#pragma unroll
        for (int e = 0; e < 2; ++e) { const float inv = powf(10000.f, -(float)(i0 + e) * (1.f / 16.f)); sincosf(pos * inv, &sn[e], &cs[e]); }
        const int off = blk * 64 + half * 32 + i0;
        { const f16x2 x1 = *(const f16x2*)(P + C_DQ + off), x2 = *(const f16x2*)(P + C_DQ + off + 16); f16x2 y1, y2;
#pragma unroll
          for (int e = 0; e < 2; ++e) { const float u1 = (float)x1[e], u2 = (float)x2[e]; y1[e] = (f16)(u1 * cs[e] - u2 * sn[e]); y2[e] = (f16)(u1 * sn[e] + u2 * cs[e]); }
          *(f16x2*)(dq + off) = y1; *(f16x2*)(dq + off + 16) = y2; }
        { const f16x2 x1 = *(const f16x2*)(P + C_DK + off), x2 = *(const f16x2*)(P + C_DK + off + 16); f16x2 y1, y2;
#pragma unroll
          for (int e = 0; e < 2; ++e) { const float u1 = (float)x1[e], u2 = (float)x2[e]; y1[e] = (f16)(u1 * cs[e] - u2 * sn[e]); y2[e] = (f16)(u1 * sn[e] + u2 * cs[e]); }
          *(f16x2*)(dk + off) = y1; *(f16x2*)(dk + off + 16) = y2; }
    }
}

struct FnetSched {
    int G, c;
    __device__ __forceinline__ bool next(int i, pg8::Unit& u) const { const int L = i * G + c; if (L >= 256) return false;
        const int sp = L & 3, nt2 = (L >> 2) & 1, mt = (L >> 3) & 7, b = L >> 6; u.pm = mt; u.pn = b * 2 + nt2; u.kt0 = sp * 16; u.tag = b * 4 + sp; return true; }
    __device__ __forceinline__ void a_ready(const pg8::Unit&) const {}
    __device__ __forceinline__ void done(const pg8::Unit&) const {}
};
struct EpiFnetPart {
    static constexpr bool PERM = true, AFTER_DRAIN = false;
    float* FP;
    __device__ __forceinline__ void operator()(const f32x4 (&acc)[2][2][4][2], const pg8::Unit& u, int wr, int wc, int fr, int fq) const {
        const int b = u.tag >> 2, sp = u.tag & 3;
        const int row0 = b * 2048 + u.pm * 256 + wr * 64 + fr, col0 = (u.pn & 1) * 256 + wc * 32 + 8 * fq;
        float* base = FP + (size_t)sp * TL * 512;
#pragma unroll
        for (int ai = 0; ai < 2; ++ai)
#pragma unroll
            for (int m = 0; m < 4; ++m) { float* rowp = base + (size_t)(row0 + ai * 128 + m * 16) * 512 + col0;
#pragma unroll
                for (int bj = 0; bj < 2; ++bj) { *(f32x4*)(rowp + bj * 128) = acc[ai][bj][m][0]; *(f32x4*)(rowp + bj * 128 + 4) = acc[ai][bj][m][1]; } }
    }
};
struct FnetCtxSched {
    int G, c;
    __device__ __forceinline__ bool next(int i, pg8::Unit& u) const { const int L = i * G + c; if (L >= 8) return false; u.pm = 0; u.pn = L; u.kt0 = 0; u.tag = L >> 1; return true; }
    __device__ __forceinline__ void a_ready(const pg8::Unit&) const {}
    __device__ __forceinline__ void done(const pg8::Unit&) const {}
};
struct EpiFnetCtx {
    static constexpr bool PERM = true, AFTER_DRAIN = false;
    f16* Y;
    __device__ __forceinline__ void operator()(const f32x4 (&acc)[2][2][4][2], const pg8::Unit& u, int wr, int wc, int fr, int fq) const {
        const int row0 = TL + u.tag * 256 + wr * 64 + fr, col0 = (u.pn & 1) * 256 + wc * 32 + 8 * fq;
#pragma unroll
        for (int ai = 0; ai < 2; ++ai)
#pragma unroll
            for (int m = 0; m < 4; ++m) { f16* rowp = Y + (size_t)(row0 + ai * 128 + m * 16) * 512 + col0;
#pragma unroll
                for (int bj = 0; bj < 2; ++bj) *(f16x8*)(rowp + bj * 128) = pack8(acc[ai][bj][m][0], acc[ai][bj][m][1]); }
    }
};
struct Merge1Sched {
    int G, c, nM;
    __device__ __forceinline__ bool next(int i, pg8::Unit& u) const { const int tix = (i >> 2) * G + c, g = i & 3; if (tix >= nM * 8) return false; int pm, pn; pg8::tile_of(tix, nM, 8, pm, pn);
        u.pm = g * 36 + pm; u.pn = g * 8 + pn; u.kt0 = 0; u.tag = g; return true; }
    __device__ __forceinline__ void a_ready(const pg8::Unit&) const {}
    __device__ __forceinline__ void done(const pg8::Unit&) const {}
};
struct EpiMerge1 {
    static constexpr bool PERM = true, AFTER_DRAIN = false;
    const f16* P; float* S32; f16* S16;
    __device__ __forceinline__ void operator()(const f32x4 (&acc)[2][2][4][2], const pg8::Unit& u, int wr, int wc, int fr, int fq) const {
        const int g = u.tag, row0 = (u.pm - g * 36) * 256 + wr * 64 + fr, col0 = (u.pn - g * 8) * 256 + wc * 32 + 8 * fq;
#pragma unroll
        for (int ai = 0; ai < 2; ++ai)
#pragma unroll
            for (int m = 0; m < 4; ++m) { const int row = row0 + ai * 128 + m * 16;
#pragma unroll
                for (int bj = 0; bj < 2; ++bj) { const int col = col0 + bj * 128;
                    const f16x8 gt = *(const f16x8*)(P + (size_t)row * NMAIN + C_GATE + g * 2048 + col);
                    f32x4 v0 = acc[ai][bj][m][0], v1 = acc[ai][bj][m][1];
#pragma unroll
                    for (int e = 0; e < 4; ++e) { v0[e] *= sigmf((float)gt[e]); v1[e] *= sigmf((float)gt[4 + e]); }
                    float* sp = S32 + (size_t)row * D + col;
                    if (g > 0) { v0 += *(const f32x4*)sp; v1 += *(const f32x4*)(sp + 4); }
                    if (g < 3) { *(f32x4*)sp = v0; *(f32x4*)(sp + 4) = v1; }
                    else *(f16x8*)(S16 + (size_t)row * D + col) = pack8(v0, v1); } }
    }
};
struct EpiMerge2 {
    static constexpr bool PERM = true, AFTER_DRAIN = false;
    const float* res_lat; const float* res_ctx; const float* mod; float* V1; int l;
    __device__ __forceinline__ void operator()(const f32x4 (&acc)[2][2][4][2], const pg8::Unit& u, int wr, int wc, int fr, int fq) const {
        const int row0 = u.pm * 256 + wr * 64 + fr, col0 = u.pn * 256 + wc * 32 + 8 * fq;
        const int br = brow_of(u.pm * 256);
        const float* gate = mod + ((size_t)(l * 5 + br) * 6 + 2) * D;
#pragma unroll
        for (int ai = 0; ai < 2; ++ai)
#pragma unroll
            for (int m = 0; m < 4; ++m) { const int row = row0 + ai * 128 + m * 16;
                const float* rs = row < TL ? res_lat + (size_t)row * D : res_ctx + (size_t)(row - TL) * D;
#pragma unroll
                for (int bj = 0; bj < 2; ++bj) { const int col = col0 + bj * 128;
                    const f32x4 g0 = *(const f32x4*)(gate + col), g1 = *(const f32x4*)(gate + col + 4), x0 = *(const f32x4*)(rs + col), x1 = *(const f32x4*)(rs + col + 4);
                    *(f32x4*)(V1 + (size_t)row * D + col) = x0 * ALPHA + g0 * acc[ai][bj][m][0]; *(f32x4*)(V1 + (size_t)row * D + col + 4) = x1 * ALPHA + g1 * acc[ai][bj][m][1]; } }
    }
};
template <int NC> struct MoeSched {
    int G, c; const int* tb;
    __device__ __forceinline__ bool next(int i, pg8::Unit& u) const { const int L = i * G + c; const int ntile = tb[33]; if (L >= ntile * NC) return false; const int rt = L / NC, pn = L % NC; const int e = tb[64 + rt];
        u.pm = rt; u.pn = e * NC + pn; u.kt0 = 0; u.tag = pn; return true; }
    __device__ __forceinline__ void a_ready(const pg8::Unit&) const {}
    __device__ __forceinline__ void done(const pg8::Unit&) const {}
};
struct EpiMoe1 {
    static constexpr bool PERM = true, AFTER_DRAIN = false;
    const float* slotw; f16* ACT;
    __device__ __forceinline__ void operator()(const f32x4 (&acc)[2][2][4][2], const pg8::Unit& u, int wr, int wc, int fr, int fq) const {
        const int row0 = u.pm * 256 + wr * 64 + fr, col0 = u.tag * 128 + wc * 32 + 8 * fq;
#pragma unroll
        for (int ai = 0; ai < 2; ++ai)
#pragma unroll
            for (int m = 0; m < 4; ++m) { const int row = row0 + ai * 128 + m * 16; const float w = slotw[row];
                f32x4 v0, v1;
#pragma unroll
                for (int e = 0; e < 4; ++e) { v0[e] = siluf(acc[ai][0][m][0][e]) * acc[ai][1][m][0][e] * w; v1[e] = siluf(acc[ai][0][m][1][e]) * acc[ai][1][m][1][e] * w; }
                *(f16x8*)(ACT + (size_t)row * 512 + col0) = pack8(v0, v1); }
    }
};
struct EpiMoe2 {
    static constexpr bool PERM = true, AFTER_DRAIN = false;
    f16* SOUT;
    __device__ __forceinline__ void operator()(const f32x4 (&acc)[2][2][4][2], const pg8::Unit& u, int wr, int wc, int fr, int fq) const {
        const int row0 = u.pm * 256 + wr * 64 + fr, col0 = u.tag * 256 + wc * 32 + 8 * fq;
#pragma unroll
        for (int ai = 0; ai < 2; ++ai)
#pragma unroll
            for (int m = 0; m < 4; ++m) { f16* rowp = SOUT + (size_t)(row0 + ai * 128 + m * 16) * D + col0;
#pragma unroll
                for (int bj = 0; bj < 2; ++bj) *(f16x8*)(rowp + bj * 128) = pack8(acc[ai][bj][m][0], acc[ai][bj][m][1]); }
    }
};
__device__ __forceinline__ void moe_tables(KA a, LAS unsigned char* lds, int l, int tid) {
    LAS int* tb = (LAS int*)(lds + TBL_OFF);
    if (tid == 0) { const gu32* cnt = (const gu32*)(a->ws + WS_CTL) + CW_CNT + 32 * l; int base = 0, nt = 0;
        for (int e = 0; e < 32; ++e) { const int ce = (int)__hip_atomic_load(cnt + e, RLX_AGENT); tb[e] = base; const int k = (ce + 255) >> 8; for (int q = 0; q < k; ++q) tb[64 + nt + q] = e; nt += k; base += k * 256; }
        tb[32] = base; tb[33] = nt; }
    __syncthreads();
}

__device__ __forceinline__ void ph_ln_route(KA a, LAS unsigned char* lds, int l, int ntok, int tid, int bid, int G) {
    const int lane = tid & 63, wave = tid >> 6;
    LAS float* hs = (LAS float*)lds;
    LAS float* lg = (LAS float*)(lds + 16 * 2050 * 4);
    const float* V1 = (const float*)(a->ws + WS_S32); float* XL = (float*)(a->ws + WS_XL); f16* H = (f16*)(a->ws + WS_H);
    const float* g1 = a->in[15] + l * D; const float* b1 = a->in[16] + l * D;
    const float* wgp = a->in[19] + (size_t)l * D * 4; const float* wrt = a->in[21] + (size_t)l * 4 * D * 8;
    int* tok_e = (int*)(a->ws + WS_ROUT); float* tok_w = (float*)(a->ws + WS_ROUT) + 2 * T; int* tok_rank = (int*)(a->ws + WS_ROUT) + 4 * T;
    gu32* cnt = (gu32*)(a->ws + WS_CTL) + CW_CNT + 32 * l;
    for (int u = bid; u < ntok / 16; u += G) {
#pragma unroll 1
        for (int q = 0; q < 2; ++q) { const int tl = wave * 2 + q, t = u * 16 + tl;
            f32x4 v[8]; row_load(V1 + (size_t)t * D, lane, v); row_ln(v, lane);
#pragma unroll
            for (int j = 0; j < 8; ++j) { const int c = 4 * (lane + 64 * j); v[j] = v[j] * *(const f32x4*)(g1 + c) + *(const f32x4*)(b1 + c); *(f32x4*)(XL + (size_t)t * D + c) = v[j]; }
            row_ln(v, lane);
            const int br = brow_of(t); const float* sh = mod_vec(a, l, br, 3); const float* sc = mod_vec(a, l, br, 4);
#pragma unroll
            for (int j = 0; j < 8; ++j) { const int c = 4 * (lane + 64 * j); const f32x4 y = v[j] * (*(const f32x4*)(sc + c) + 1.f) + *(const f32x4*)(sh + c);
                f16x4 o; o[0] = (f16)y[0]; o[1] = (f16)y[1]; o[2] = (f16)y[2]; o[3] = (f16)y[3]; *(f16x4*)(H + (size_t)t * D + c) = o;
                hs[tl * 2050 + c] = y[0]; hs[tl * 2050 + c + 1] = y[1]; hs[tl * 2050 + c + 2] = y[2]; hs[tl * 2050 + c + 3] = y[3]; } }
        __syncthreads();
        f32x4 acc[3];
#pragma unroll
        for (int n = 0; n < 3; ++n) acc[n] = (f32x4){0.f, 0.f, 0.f, 0.f};
        { const int ti = lane & 15, kq = lane >> 4;
#pragma unroll 2
          for (int kk = 0; kk < 64; ++kk) { const int k = wave * 256 + kk * 4 + kq; const float av = hs[ti * 2050 + k];
              const float b0 = ti < 4 ? wgp[(size_t)k * 4 + ti] : wrt[((size_t)((ti - 4) >> 3) * D + k) * 8 + ((ti - 4) & 7)];
              const int n1 = 16 + ti - 4; const float b1v = wrt[((size_t)(n1 >> 3) * D + k) * 8 + (n1 & 7)];
              const int n2 = 32 + ti - 4; const float b2v = ti < 4 ? wrt[((size_t)(n2 >> 3) * D + k) * 8 + (n2 & 7)] : 0.f;
              acc[0] = __builtin_amdgcn_mfma_f32_16x16x4f32(av, b0, acc[0], 0, 0, 0); acc[1] = __builtin_amdgcn_mfma_f32_16x16x4f32(av, b1v, acc[1], 0, 0, 0); acc[2] = __builtin_amdgcn_mfma_f32_16x16x4f32(av, b2v, acc[2], 0, 0, 0); } }
        __syncthreads();
        { const int n = lane & 15, tq = lane >> 4;
#pragma unroll
          for (int nt = 0; nt < 3; ++nt)
#pragma unroll
              for (int e = 0; e < 4; ++e) hs[(wave * 16 + 4 * tq + e) * 48 + nt * 16 + n] = acc[nt][e]; }
        __syncthreads();
        for (int o = tid; o < 16 * 48; o += NTHR) { const int tl = o / 48, n = o % 48; float s = 0.f;
#pragma unroll
            for (int w2 = 0; w2 < 8; ++w2) s += hs[(w2 * 16 + tl) * 48 + n];
            if (n < 4) s += a->in[20][l * 4 + n]; else if (n < 36) s += a->in[22][l * 32 + (n - 4)];
            lg[tl * 48 + n] = s; }
        __syncthreads();
        if (tid < 16) { const int t = u * 16 + tid; const LAS float* L = lg + tid * 48;
            int gs = 0; float gm = L[0];
#pragma unroll
            for (int g = 1; g < 4; ++g) if (L[g] > gm) { gm = L[g]; gs = g; }
            float den = 0.f;
#pragma unroll
            for (int g = 0; g < 4; ++g) den += expf(L[g] - gm);
            const float gw = 1.f / den;
            const LAS float* E = L + 4 + gs * 8;
            int i0 = 0; float v0 = E[0];
#pragma unroll
            for (int e = 1; e < 8; ++e) if (E[e] > v0) { v0 = E[e]; i0 = e; }
            int i1 = -1; float v1 = -3.0e38f;
#pragma unroll
            for (int e = 0; e < 8; ++e) if (e != i0 && E[e] > v1) { v1 = E[e]; i1 = e; }
            const float ex = expf(v1 - v0), w0 = gw / (1.f + ex), w1 = gw * ex / (1.f + ex);
            const int e0 = gs * 8 + i0, e1 = gs * 8 + i1;
            const int r0 = (int)__hip_atomic_fetch_add(cnt + e0, 1u, RLX_AGENT), r1 = (int)__hip_atomic_fetch_add(cnt + e1, 1u, RLX_AGENT);
            tok_e[2 * t] = e0; tok_e[2 * t + 1] = e1; tok_w[2 * t] = w0; tok_w[2 * t + 1] = w1; tok_rank[2 * t] = r0; tok_rank[2 * t + 1] = r1; }
        __syncthreads();
    }
}
__device__ __forceinline__ void ph_scatter(KA a, LAS unsigned char* lds, int l, int ntok, int tid, int bid, int G) {
    moe_tables(a, lds, l, tid);
    const LAS int* tb = (const LAS int*)(lds + TBL_OFF);
    if (bid == 0 && tid < 192) ((int*)(a->ws + WS_TILES))[tid] = tb[tid];
    const int lane = tid & 63, wave = tid >> 6;
    const int* tok_e = (const int*)(a->ws + WS_ROUT); const float* tok_w = (const float*)(a->ws + WS_ROUT) + 2 * T; const int* tok_rank = (const int*)(a->ws + WS_ROUT) + 4 * T; int* tok_slot = (int*)(a->ws + WS_ROUT) + 6 * T;
    float* slotw = (float*)(a->ws + WS_SLOTW); const f16* H = (const f16*)(a->ws + WS_H); f16* AS = (f16*)(a->ws + WS_ASORT);
    for (int t = bid * NWAVES + wave; t < ntok; t += G * NWAVES) {
        const u32x4* src = (const u32x4*)(H + (size_t)t * D);
        u32x4 v[4];
#pragma unroll
        for (int j = 0; j < 4; ++j) v[j] = src[lane + 64 * j];
#pragma unroll
        for (int k = 0; k < 2; ++k) { const int slot = tb[tok_e[2 * t + k]] + tok_rank[2 * t + k];
            u32x4* dst = (u32x4*)(AS + (size_t)slot * D);
#pragma unroll
            for (int j = 0; j < 4; ++j) dst[lane + 64 * j] = v[j];
            if (lane == 0) { slotw[slot] = tok_w[2 * t + k]; tok_slot[2 * t + k] = slot; } }
    }
}
#define SB0() __builtin_amdgcn_sched_barrier(0)
__device__ __forceinline__ void ph_final(KA a, int l, int ntok, int tid, int bid, int G) {
    const int lane = tid & 63, wave = __builtin_amdgcn_readfirstlane(tid >> 6);
    const int* tok_slot = (const int*)(a->ws + WS_ROUT) + 6 * T; const f16* SOUT = (const f16*)(a->ws + WS_SOUT);
    float* XL = (float*)(a->ws + WS_XL); f16* H = (f16*)(a->ws + WS_H);
    const float* g2 = a->in[17] + l * D; const float* b2 = a->in[18] + l * D;
    for (int t = bid * NWAVES + wave; t < ntok; t += G * NWAVES) {
        const int s0 = __builtin_amdgcn_readfirstlane(tok_slot[2 * t]), s1 = __builtin_amdgcn_readfirstlane(tok_slot[2 * t + 1]); const int br = brow_of(t);
        const float* gate = mod_vec(a, l, br, 5) + 4 * lane; const float* xr = XL + (size_t)t * D + 4 * lane;
        const f16* fa = SOUT + (size_t)s0 * D + 4 * lane; const f16* fb = SOUT + (size_t)s1 * D + 4 * lane;
        f32x4 v[8];
#pragma unroll
        for (int jj = 0; jj < 8; jj += 2) {
#pragma unroll
            for (int j = jj; j < jj + 2; ++j) { const f32x4 x = *(const f32x4*)(xr + 256 * j); const f16x4 ya = *(const f16x4*)(fa + 256 * j), yb = *(const f16x4*)(fb + 256 * j); const f32x4 gt = *(const f32x4*)(gate + 256 * j);
                f32x4 f; f[0] = (float)ya[0] + (float)yb[0]; f[1] = (float)ya[1] + (float)yb[1]; f[2] = (float)ya[2] + (float)yb[2]; f[3] = (float)ya[3] + (float)yb[3];
                v[j] = x * ALPHA + gt * f; }
            SB0();
        }
        row_ln(v, lane);
        SB0();
        const float* g2p = g2 + 4 * lane; const float* b2p = b2 + 4 * lane;
#pragma unroll
        for (int jj = 0; jj < 8; jj += 4) {
#pragma unroll
            for (int j = jj; j < jj + 4; ++j) v[j] = v[j] * *(const f32x4*)(g2p + 256 * j) + *(const f32x4*)(b2p + 256 * j);
            SB0();
        }
        if (l == 1) {
            float* op = a->out + (size_t)t * D + 4 * lane;
#pragma unroll
            for (int j = 0; j < 8; ++j) *(f32x4*)(op + 256 * j) = v[j];
        } else {
            float* op = XL + (size_t)t * D + 4 * lane;
#pragma unroll
            for (int j = 0; j < 8; ++j) *(f32x4*)(op + 256 * j) = v[j];
            SB0();
            row_ln(v, lane);
            SB0();
            const float* sh = mod_vec(a, l + 1, br, 0) + 4 * lane; const float* sc = mod_vec(a, l + 1, br, 1) + 4 * lane; f16* hp = H + (size_t)t * D + 4 * lane;
#pragma unroll
            for (int jj = 0; jj < 8; jj += 4) {
#pragma unroll
                for (int j = jj; j < jj + 4; ++j) { const f32x4 y = v[j] * (*(const f32x4*)(sc + 256 * j) + 1.f) + *(const f32x4*)(sh + 256 * j);
                    f16x4 o; o[0] = (f16)y[0]; o[1] = (f16)y[1]; o[2] = (f16)y[2]; o[3] = (f16)y[3]; *(f16x4*)(hp + 256 * j) = o; }
                SB0();
            }
        }
        SB0();
    }
}

#ifndef PHASE_ATTR
#define PHASE_ATTR __forceinline__
#endif
#define PH_PROLOG int tid_ = threadIdx.x, bid_ = blockIdx.x; asm volatile("" : "+v"(tid_), "+s"(bid_), "+s"(a)); const int tid = tid_, bid = bid_, G = gridDim.x, lane = tid & 63, wave = __builtin_amdgcn_readfirstlane(tid >> 6); const int gw = bid * NWAVES + wave, NGW = G * NWAVES; (void)lane; (void)gw; (void)NGW;
__device__ PHASE_ATTR void P_mod_tables(KA a, LAS unsigned char* lds) { PH_PROLOG ph_mod_tables(a, lds, tid, bid, G); }
__device__ PHASE_ATTR void P_convert(KA a, LAS unsigned char* lds) { PH_PROLOG ph_convert(a, lds, tid, bid, G); }
__device__ PHASE_ATTR void P_inproj(KA a, LAS unsigned char* lds, int l) {
    PH_PROLOG
    pg8::Gemm g{a->ws, a->ws, 2048, 32}; InProjSched S{G, bid, l}; EpiInProj E{a->ws, WT0 + WT_STRIDE * l};
    pg8::gemm_phase<EpiInProj, InProjSched, true, true>(lds + RING_OFF, g, S, E);
}
__device__ PHASE_ATTR void P_gla1(KA a, LAS unsigned char* lds, int l) {
    PH_PROLOG
    LAS float* F = (LAS float*)lds;
    for (int u = bid; u < 1152; u += G) {
        int s, h, dir, c;
        if (u < 1024) { s = u >> 8; h = (u >> 6) & 3; dir = (u >> 5) & 1; c = u & 31; } else { const int v = u - 1024; s = 4 + (v >> 5); h = (v >> 3) & 3; dir = (v >> 2) & 1; c = v & 3; }
        gla_g1_unit(a, F, l, s, h, dir, c, tid);
    }
}
__device__ PHASE_ATTR void P_na_rope(KA a, int l) {
    PH_PROLOG
    for (int u = gw; u < 2048; u += NGW) na_unit(a, l, u >> 9, (u >> 7) & 3, true, (u >> 2) & 31, u & 3, 0, lane);
    if (l == 0) for (int u = gw; u < 256; u += NGW) na_unit(a, l, u >> 6, (u >> 4) & 3, false, 0, 0, u & 15, lane);
    for (int t = gw; t < T; t += NGW) rope_row(a, t, lane);
}
__device__ PHASE_ATTR void P_fnet2(KA a, LAS unsigned char* lds) {
    PH_PROLOG
    pg8::Gemm g{a->ws + WS_TBLL, a->ws + WS_FTL, 4096, 16}; FnetSched S{G, bid}; EpiFnetPart E{(float*)(a->ws + WS_FP)};
    pg8::gemm_phase<EpiFnetPart, FnetSched, true, true>(lds + RING_OFF, g, S, E);
}
__device__ PHASE_ATTR void P_fnet2c(KA a, LAS unsigned char* lds) {
    PH_PROLOG
    pg8::Gemm g{a->ws + WS_TBLC, a->ws + WS_FTC, 512, 8}; FnetCtxSched S{G, bid}; EpiFnetCtx E{(f16*)(a->ws + WS_YALL) + (size_t)2 * T * 512};
    pg8::gemm_phase<EpiFnetCtx, FnetCtxSched, true, true>(lds + RING_OFF, g, S, E);
}
__device__ PHASE_ATTR void P_scan_diff(KA a, int l) {
    PH_PROLOG
    gla_scan(a, tid, bid, G);
    const float lam_init = 0.8f - 0.6f * expf(-0.3f * (float)l);
    const float* dl = a->in[11] + l * 256;
    const float lam = expf(wave_sum(dl[lane] * dl[64 + lane], lane)) - expf(wave_sum(dl[128 + lane] * dl[192 + lane], lane)) + lam_init;
    for (int u = gw; u < 2048; u += NGW) diff_unit(a, l, u >> 9, (u >> 7) & 3, true, u & 127, lam, lam_init, lane);
    if (l == 0) for (int u = gw; u < 256; u += NGW) diff_unit(a, l, u >> 6, (u >> 4) & 3, false, u & 15, lam, lam_init, lane);
}
__device__ PHASE_ATTR void P_gla3(KA a, LAS unsigned char* lds, int l) {
    PH_PROLOG
    LAS float* F = (LAS float*)lds;
    const int ng3 = (l == 0) ? 576 : 512;
    for (int u = bid; u < ng3; u += G) {
        int s, h, c;
        if (u < 512) { s = u >> 7; h = (u >> 5) & 3; c = u & 31; } else { const int v = u - 512; s = 4 + (v >> 4); h = (v >> 2) & 3; c = v & 3; }
        gla_g3_unit(a, F, l, s, h, c, tid);
    }
    const float* FP = (const float*)(a->ws + WS_FP); f16* Y2 = (f16*)(a->ws + WS_YALL) + (size_t)2 * T * 512;
    for (int t = gw; t < TL; t += NGW) {
        f32x4 s0 = (f32x4){0.f, 0.f, 0.f, 0.f}, s1 = s0;
#pragma unroll
        for (int sp = 0; sp < 4; ++sp) { const float* p = FP + ((size_t)sp * TL + t) * 512 + 8 * lane; s0 += *(const f32x4*)p; s1 += *(const f32x4*)(p + 4); }
        *(f16x8*)(Y2 + (size_t)t * 512 + 8 * lane) = pack8(s0, s1);
    }
}
__device__ PHASE_ATTR void P_merge1(KA a, LAS unsigned char* lds, int l) {
    PH_PROLOG
    pg8::Gemm g{a->ws + WS_YALL, a->ws + WS_WBR + (size_t)l * 4 * D * 512 * 2, 512, 8}; Merge1Sched S{G, bid, (l == 0) ? 36 : 32};
    EpiMerge1 E{(const f16*)(a->ws + WS_P), (float*)(a->ws + WS_S32), (f16*)(a->ws + WS_S16)};
    pg8::gemm_phase<EpiMerge1, Merge1Sched, true, true>(lds + RING_OFF, g, S, E);
}
__device__ PHASE_ATTR void P_merge2(KA a, LAS unsigned char* lds, int l) {
    PH_PROLOG
    pg8::Gemm g{a->ws + WS_S16, a->ws + WS_WOUT + (size_t)l * D * D * 2, 2048, 32}; Merge2Sched S{G, bid, (l == 0) ? 36 : 32};
    const float* XLc = (const float*)(a->ws + WS_XL);
    EpiMerge2 E{l == 0 ? a->in[0] : XLc, l == 0 ? a->in[2] : XLc + (size_t)TL * D, (const float*)(a->ws + WS_MOD), (float*)(a->ws + WS_S32), l};
    pg8::gemm_phase<EpiMerge2, Merge2Sched, true, true>(lds + RING_OFF, g, S, E);
}
__device__ PHASE_ATTR void P_ln_route(KA a, LAS unsigned char* lds, int l) { PH_PROLOG ph_ln_route(a, lds, l, l == 0 ? T : TL, tid, bid, G); }
__device__ PHASE_ATTR void P_scatter(KA a, LAS unsigned char* lds, int l) { PH_PROLOG ph_scatter(a, lds, l, l == 0 ? T : TL, tid, bid, G); }
__device__ PHASE_ATTR void P_moe1(KA a, LAS unsigned char* lds, int l) {
    PH_PROLOG
    pg8::Gemm g{a->ws + WS_ASORT, a->ws + WS_WGU + (size_t)l * 32 * 1024 * D * 2, 2048, 32}; MoeSched<4> S{G, bid, (const int*)(a->ws + WS_TILES)};
    EpiMoe1 E{(const float*)(a->ws + WS_SLOTW), (f16*)(a->ws + WS_ACT)};
    pg8::gemm_phase<EpiMoe1, MoeSched<4>, true, true>(lds + RING_OFF, g, S, E);
}
__device__ PHASE_ATTR void P_moe2(KA a, LAS unsigned char* lds, int l) {
    PH_PROLOG
    pg8::Gemm g{a->ws + WS_ACT, a->ws + WS_WDN + (size_t)l * 32 * D * 512 * 2, 512, 8}; MoeSched<8> S{G, bid, (const int*)(a->ws + WS_TILES)};
    EpiMoe2 E{(f16*)(a->ws + WS_SOUT)};
    pg8::gemm_phase<EpiMoe2, MoeSched<8>, true, true>(lds + RING_OFF, g, S, E);
}
__device__ PHASE_ATTR void P_final(KA a, int l) { PH_PROLOG ph_final(a, l, l == 0 ? T : TL, tid, bid, G); }

#ifndef PH_MASK
#define PH_MASK 0xFFFF
#endif
#define EN(j) (((PH_MASK) >> (j)) & 1)
__global__ void __launch_bounds__(NTHR, 2) mk_fwd(Args args) {
    extern __shared__ __attribute__((aligned(16))) unsigned char lds_raw[];
    LAS unsigned char* lds = (LAS unsigned char*)lds_raw;
    KA a = (KA)__builtin_amdgcn_kernarg_segment_ptr();
    volatile LAS unsigned* MISC = (volatile LAS unsigned*)(lds + MISC_OFF);
    if (threadIdx.x < 128) MISC[threadIdx.x] = 0u;
    __syncthreads();
#if ONE_LAUNCH
    (void)xcd_barrier_post((unsigned*)(a->ws + WS_CTL) + CW_BAR, MISC + 8);
#endif
    const int lo = args.ph_lo, hi = args.ph_hi;
#define IN(k) (lo <= (k) && (k) < hi)
#define SEAM(k) do { if (IN(k) && IN((k) + 1)) { XcdBarrier bar; bar.bar = (unsigned*)(a->ws + WS_CTL) + CW_BAR; bar.x = xb_xcc_id(); bar.st = (volatile LAS unsigned*)(lds + MISC_OFF) + 8; xcd_barrier(bar); } } while (0)
    if (EN(0) && IN(0)) P_mod_tables(a, lds);
    SEAM(0);
    if (EN(1) && IN(1)) P_convert(a, lds);
    SEAM(1);
#define LAYER_BODY(l) { \
        const int pb = 2 + 11 * l; \
        if (EN(2) && IN(pb + 0)) P_inproj(a, lds, l); \
        SEAM(pb + 0); \
        if (EN(3) && IN(pb + 1)) { P_gla1(a, lds, l); P_na_rope(a, l); } \
        SEAM(pb + 1); \
        if (EN(4) && IN(pb + 2)) { P_fnet2(a, lds); if (l == 0) P_fnet2c(a, lds); P_scan_diff(a, l); } \
        SEAM(pb + 2); \
        if (EN(5) && IN(pb + 3)) P_gla3(a, lds, l); \
        SEAM(pb + 3); \
        if (EN(6) && IN(pb + 4)) P_merge1(a, lds, l); \
        SEAM(pb + 4); \
        if (EN(7) && IN(pb + 5)) P_merge2(a, lds, l); \
        SEAM(pb + 5); \
        if (EN(8) && IN(pb + 6)) P_ln_route(a, lds, l); \
        SEAM(pb + 6); \
        if (EN(9) && IN(pb + 7)) P_scatter(a, lds, l); \
        SEAM(pb + 7); \
        if (EN(10) && IN(pb + 8)) P_moe1(a, lds, l); \
        SEAM(pb + 8); \
        if (EN(11) && IN(pb + 9)) P_moe2(a, lds, l); \
        SEAM(pb + 9); \
        if (EN(12) && IN(pb + 10)) P_final(a, l); \
        SEAM(pb + 10); \
    }
    LAYER_BODY(0)
    LAYER_BODY(1)
#undef LAYER_BODY
#undef IN
#undef SEAM
}

extern "C" void kernel_launch(void* const* d_in, const int* in_sizes, int n_in, void* d_out, int out_size, void* d_ws, size_t ws_size, hipStream_t stream) {
    static int grid = 0;
    if (grid == 0) {
        if (n_in != 25 || out_size != TL * D || ws_size < WS_END) { fprintf(stderr, "kernel_launch: unexpected shapes (n_in %d, out %d, ws %zu); nothing launched\n", n_in, out_size, ws_size); grid = -1; return; }
        int dev = 0, cus = 0, per_cu = 0;
        if (hipGetDevice(&dev) != hipSuccess || hipDeviceGetAttribute(&cus, hipDeviceAttributeMultiprocessorCount, dev) != hipSuccess) { grid = -1; return; }
        if (hipFuncSetAttribute((const void*)mk_fwd, hipFuncAttributeMaxDynamicSharedMemorySize, LDS_BYTES) != hipSuccess) { fprintf(stderr, "kernel_launch: hipFuncSetAttribute failed\n"); grid = -1; return; }
        if (hipOccupancyMaxActiveBlocksPerMultiprocessor(&per_cu, (const void*)mk_fwd, NTHR, LDS_BYTES) != hipSuccess || per_cu < 1) fprintf(stderr, "kernel_launch: occupancy query says %d\n", per_cu);
        (void)hipGetLastError();
        grid = cus;
    }
    if (grid < 0) return;
    if (hipMemsetAsync((char*)d_ws + WS_CTL, 0, CTL_ZERO_BYTES, stream) != hipSuccess) return;
    Args a; memset(&a, 0, sizeof(a));
    for (int i = 0; i < 25; ++i) a.in[i] = (const float*)d_in[i];
    a.out = (float*)d_out; a.ws = (unsigned char*)d_ws;
#if ONE_LAUNCH
    a.ph_lo = 0; a.ph_hi = N_PHASES;
    hipLaunchKernelGGL(mk_fwd, dim3(grid), dim3(NTHR), LDS_BYTES, stream, a);
#else
    for (int k = 0; k < N_PHASES; ++k) { a.ph_lo = k; a.ph_hi = k + 1; hipLaunchKernelGGL(mk_fwd, dim3(grid), dim3(NTHR), LDS_BYTES, stream, a); }
#endif
}
```
